# Optimizing an MI355X kernel written in HIP

```python
import math
import jax, jax.numpy as jnp
from jax import lax
import numpy as np

D_MODEL = 2048
BATCH = 8
SEQ = 2048
DEPTH = 2

N_A_LAYERS = DEPTH // 2
N_B_LAYERS = DEPTH - N_A_LAYERS
PLE_DIM = 256
NORM_EPS = 1e-6
SSM_GROUP = 16
SSM_GROUPS = D_MODEL // SSM_GROUP
SSM_STATE = 64
SSM_CHUNK = 128
DT_MIN = 0.001
DT_MAX = 0.1
HEAD_DIM = 128
N_Q_HEADS = D_MODEL // HEAD_DIM
N_KV_HEADS = 8
KV_REP = N_Q_HEADS // N_KV_HEADS
DILATED_PATTERNS = ((128, 1), (512, 4), (2048, 16))
N_PATTERNS = len(DILATED_PATTERNS)
ATTN_BLOCK = 128
ROPE_THETA = 10000.0
NEG_INF = -1e30
N_GROUPS = 4
EXPERTS_PER_GROUP = 8
N_EXPERTS = N_GROUPS * EXPERTS_PER_GROUP
TOP_K_IN_GROUP = 2
EXPERT_HIDDEN = D_MODEL // 4

kernel_name = "yoco_s5_dilated_hmoe_trunk"

F32 = jnp.float32


def _rmsnorm(a, g):
    af = a.astype(F32)
    r = lax.rsqrt(jnp.mean(af * af, axis=-1, keepdims=True) + NORM_EPS)
    return (af * r).astype(a.dtype) * g


def _rope_tables(length):
    inv = 1.0 / (ROPE_THETA ** (jnp.arange(0, HEAD_DIM, 2, dtype=F32) / HEAD_DIM))
    ang = jnp.arange(length, dtype=F32)[:, None] * inv[None, :]
    return jnp.cos(ang), jnp.sin(ang)


def _rope(a, cos, sin):
    a1, a2 = jnp.split(a.astype(F32), 2, axis=-1)
    c = cos[None, :, None, :]
    s = sin[None, :, None, :]
    return jnp.concatenate([a1 * c - a2 * s, a2 * c + a1 * s], axis=-1).astype(a.dtype)


def _ssm_combine(left, right):
    a_l, b_l = left
    a_r, b_r = right
    return a_r * a_l, a_r * b_l + b_r


def _s5_mixer(u, a_re, a_im, log_dt, b_re, b_im, c_re, c_im, d_skip, w_glu, b_glu):
    bsz, length, _ = u.shape
    n_chunks = length // SSM_CHUNK
    uf = u.astype(F32).reshape(bsz, n_chunks, SSM_CHUNK, SSM_GROUPS, SSM_GROUP)
    uf = uf.transpose(1, 0, 2, 3, 4)
    lam = lax.complex(a_re.astype(F32), a_im.astype(F32))
    dt = jnp.exp(log_dt.astype(F32))[:, None]
    lam_bar = jnp.exp(lam * dt)
    b_mat = lax.complex(b_re.astype(F32), b_im.astype(F32))
    b_bar = ((lam_bar - 1.0) / lam)[..., None] * b_mat
    c_mat = lax.complex(c_re.astype(F32), c_im.astype(F32))
    a_chunk = jnp.broadcast_to(lam_bar, (SSM_CHUNK, SSM_GROUPS, SSM_STATE))[None]

    def chunk_step(h_prev, u_c):
        bu = jnp.einsum('btgc,gpc->btgp', u_c.astype(jnp.complex64), b_bar)
        a_cum, s = lax.associative_scan(_ssm_combine, (a_chunk, bu), axis=1)
        s = s + a_cum * h_prev[:, None]
        y = jnp.einsum('btgp,gcp->btgc', s, c_mat).real
        return s[:, -1], y

    h0 = jnp.zeros((bsz, SSM_GROUPS, SSM_STATE), jnp.complex64)
    _, ys = lax.scan(chunk_step, h0, uf)
    y = ys.transpose(1, 0, 2, 3, 4).reshape(bsz, length, D_MODEL)
    y = y + d_skip.astype(F32) * u.astype(F32)
    g = jax.nn.gelu(y).astype(u.dtype)
    z = g @ w_glu + b_glu
    val, gate = jnp.split(z, 2, axis=-1)
    return (val.astype(F32) * jax.nn.sigmoid(gate.astype(F32))).astype(u.dtype)


def _dilated_window_attention(q, k, v, dilation, n_steps):
    bsz, length, _, _ = q.shape
    m_len = length // dilation
    nblk = -(-m_len // ATTN_BLOCK)
    m_pad = nblk * ATTN_BLOCK

    def strided(a):
        return a.reshape(bsz, m_len, dilation, a.shape[2], HEAD_DIM).transpose(0, 2, 1, 3, 4)

    qs = jnp.pad(strided(q), ((0, 0), (0, 0), (0, m_pad - m_len), (0, 0), (0, 0)))
    qs = qs.reshape(bsz, dilation, nblk, ATTN_BLOCK, N_KV_HEADS, KV_REP, HEAD_DIM)

    def key_blocks(a):
        a = jnp.pad(strided(a), ((0, 0), (0, 0), (ATTN_BLOCK, m_pad - m_len), (0, 0), (0, 0)))
        a = a.reshape(bsz, dilation, nblk + 1, ATTN_BLOCK, N_KV_HEADS, HEAD_DIM)
        return jnp.concatenate([a[:, :, :-1], a[:, :, 1:]], axis=3)

    kb = key_blocks(k)
    vb = key_blocks(v)
    scale = HEAD_DIM ** -0.5
    scores = jnp.einsum('brnqhgd,brnshd->brnhgqs', qs, kb, preferred_element_type=F32) * scale
    qi = jnp.arange(ATTN_BLOCK)[:, None]
    si = jnp.arange(2 * ATTN_BLOCK)[None, :]
    dist = ATTN_BLOCK + qi - si
    band = (dist >= 0) & (dist <= n_steps)
    key_pos = (jnp.arange(nblk)[:, None] - 1) * ATTN_BLOCK + jnp.arange(2 * ATTN_BLOCK)[None, :]
    mask = band[None] & (key_pos >= 0)[:, None, :]
    scores = jnp.where(mask[:, None, None], scores, NEG_INF)
    m = jnp.max(scores, axis=-1, keepdims=True)
    e = jnp.exp(scores - m)
    den = jnp.sum(e, axis=-1, keepdims=True)
    o = jnp.einsum('brnhgqs,brnshd->brnhgqd', e, vb.astype(F32)) / den
    lse = (m + jnp.log(den))[..., 0]
    o = o.transpose(0, 1, 2, 5, 3, 4, 6).reshape(bsz, dilation, m_pad, N_Q_HEADS, HEAD_DIM)[:, :, :m_len]
    o = o.transpose(0, 2, 1, 3, 4).reshape(bsz, length, N_Q_HEADS, HEAD_DIM)
    lse = lse.transpose(0, 1, 2, 5, 3, 4).reshape(bsz, dilation, m_pad, N_Q_HEADS)[:, :, :m_len]
    lse = lse.transpose(0, 2, 1, 3).reshape(bsz, length, N_Q_HEADS)
    return o, lse


def _dilated_mixer(u, w_q, w_o, k, v, cos, sin):
    bsz, length, _ = u.shape
    q = (u @ w_q).reshape(bsz, length, N_PATTERNS * N_Q_HEADS, HEAD_DIM)
    q = _rope(q, cos, sin).reshape(bsz, length, N_PATTERNS, N_Q_HEADS, HEAD_DIM)
    outs, lses = [], []
    for g, (window, dilation) in enumerate(DILATED_PATTERNS):
        o, lse = _dilated_window_attention(q[:, :, g], k, v, dilation, window // dilation)
        outs.append(o)
        lses.append(lse)
    wts = jax.nn.softmax(jnp.stack(lses, axis=0), axis=0)
    o = jnp.einsum('pblh,pblhd->blhd', wts, jnp.stack(outs, axis=0))
    return o.reshape(bsz, length, N_Q_HEADS * HEAD_DIM).astype(u.dtype) @ w_o


def _hier_moe(u, r_grp_w, r_grp_b, r_exp_w, r_exp_b, w_gate, w_up, w_down):
    bsz, length, _ = u.shape
    t = u.reshape(-1, D_MODEL)
    n_tok = t.shape[0]
    grp_logits = (t @ r_grp_w + r_grp_b).astype(F32)
    grp_prob = jax.nn.softmax(grp_logits, axis=-1)
    grp_idx = jnp.argmax(grp_logits, axis=-1)
    grp_w = jnp.take_along_axis(grp_prob, grp_idx[:, None], axis=-1)
    exp_logits = (t @ r_exp_w + r_exp_b).astype(F32).reshape(n_tok, N_GROUPS, EXPERTS_PER_GROUP)
    sel = jnp.take_along_axis(exp_logits, grp_idx[:, None, None], axis=1)[:, 0]
    top_v, top_i = lax.top_k(sel, TOP_K_IN_GROUP)
    top_w = jax.nn.softmax(top_v, axis=-1) * grp_w
    expert_id = grp_idx[:, None] * EXPERTS_PER_GROUP + top_i
    gates = jnp.einsum('tk,tke->te', top_w, jax.nn.one_hot(expert_id, N_EXPERTS, dtype=F32))

    def expert_step(acc, args):
        wg, wu, wd, gate_e = args
        hid = jax.nn.silu(t @ wg) * (t @ wu)
        return acc + gate_e[:, None].astype(t.dtype) * (hid @ wd), None

    acc, _ = lax.scan(expert_step, jnp.zeros_like(t), (w_gate, w_up, w_down, gates.T))
    return acc.reshape(bsz, length, D_MODEL)


def _per_layer_embedding(h, p_i, norm_g, w_gate, w_proj):
    gate = jax.nn.sigmoid((_rmsnorm(h, norm_g) @ w_gate).astype(F32))
    return (gate * (p_i @ w_proj).astype(F32)).astype(h.dtype)


def setup_inputs(seed: int = 0) -> dict:
    key = jax.random.key(seed)
    ks = iter(jax.random.split(key, 40))

    def nrm(shape, scale):
        return jax.random.normal(next(ks), shape, F32) * scale

    def gain(shape):
        return 1.0 + nrm(shape, 0.01)

    na, nb, dep = N_A_LAYERS, N_B_LAYERS, DEPTH
    g, pst, gc = SSM_GROUPS, SSM_STATE, SSM_GROUP
    qw = N_PATTERNS * N_Q_HEADS * HEAD_DIM
    kvw = N_KV_HEADS * HEAD_DIM
    return {
        "x": nrm((BATCH, SEQ, D_MODEL), 1.0),
        "p": nrm((DEPTH, BATCH, SEQ, PLE_DIM), 1.0),
        "s5_norm_g": gain((na, D_MODEL)),
        "s5_a_re": -0.5 + nrm((na, g, pst), 0.01),
        "s5_a_im": math.pi * jnp.arange(pst, dtype=F32)[None, None, :] + nrm((na, g, pst), 0.01),
        "s5_log_dt": jax.random.uniform(next(ks), (na, g), F32, math.log(DT_MIN), math.log(DT_MAX)),
        "s5_b_re": nrm((na, g, pst, gc), (2.0 * gc) ** -0.5),
        "s5_b_im": nrm((na, g, pst, gc), (2.0 * gc) ** -0.5),
        "s5_c_re": nrm((na, g, gc, pst), pst ** -0.5),
        "s5_c_im": nrm((na, g, gc, pst), pst ** -0.5),
        "s5_d": nrm((na, D_MODEL), 1.0),
        "s5_w_glu": nrm((na, D_MODEL, 2 * D_MODEL), D_MODEL ** -0.5),
        "s5_b_glu": nrm((na, 2 * D_MODEL), 0.01),
        "kv_norm_g": gain((D_MODEL,)),
        "w_k": nrm((D_MODEL, kvw), D_MODEL ** -0.5),
        "w_v": nrm((D_MODEL, kvw), D_MODEL ** -0.5),
        "attn_norm_g": gain((nb, D_MODEL)),
        "w_q": nrm((nb, D_MODEL, qw), D_MODEL ** -0.5),
        "w_o": nrm((nb, N_Q_HEADS * HEAD_DIM, D_MODEL), (N_Q_HEADS * HEAD_DIM) ** -0.5),
        "ffn_norm_g": gain((dep, D_MODEL)),
        "router_grp_w": nrm((dep, D_MODEL, N_GROUPS), D_MODEL ** -0.5),
        "router_grp_b": nrm((dep, N_GROUPS), 0.01),
        "router_exp_w": nrm((dep, D_MODEL, N_EXPERTS), D_MODEL ** -0.5),
        "router_exp_b": nrm((dep, N_EXPERTS), 0.01),
        "w_gate": nrm((dep, N_EXPERTS, D_MODEL, EXPERT_HIDDEN), D_MODEL ** -0.5),
        "w_up": nrm((dep, N_EXPERTS, D_MODEL, EXPERT_HIDDEN), D_MODEL ** -0.5),
        "w_down": nrm((dep, N_EXPERTS, EXPERT_HIDDEN, D_MODEL), EXPERT_HIDDEN ** -0.5),
        "ple_norm_g": gain((dep, D_MODEL)),
        "ple_gate_w": nrm((dep, D_MODEL, D_MODEL), D_MODEL ** -0.5),
        "ple_proj_w": nrm((dep, PLE_DIM, D_MODEL), PLE_DIM ** -0.5),
        "final_norm_g": gain((D_MODEL,)),
    }


def reference(x, p, s5_norm_g, s5_a_re, s5_a_im, s5_log_dt, s5_b_re, s5_b_im, s5_c_re, s5_c_im,
              s5_d, s5_w_glu, s5_b_glu, kv_norm_g, w_k, w_v, attn_norm_g, w_q, w_o,
              ffn_norm_g, router_grp_w, router_grp_b, router_exp_w, router_exp_b,
              w_gate, w_up, w_down, ple_norm_g, ple_gate_w, ple_proj_w, final_norm_g):
    bsz, length, _ = x.shape
    cos, sin = _rope_tables(length)
    h = x
    k_shared = None
    v_shared = None
    for i in range(DEPTH):
        if i < N_A_LAYERS:
            h = h + _s5_mixer(_rmsnorm(h, s5_norm_g[i]), s5_a_re[i], s5_a_im[i], s5_log_dt[i],
                              s5_b_re[i], s5_b_im[i], s5_c_re[i], s5_c_im[i], s5_d[i],
                              s5_w_glu[i], s5_b_glu[i])
        else:
            j = i - N_A_LAYERS
            if j == 0:
                kv_in = _rmsnorm(h, kv_norm_g)
                k_shared = _rope((kv_in @ w_k).reshape(bsz, length, N_KV_HEADS, HEAD_DIM), cos, sin)
                v_shared = (kv_in @ w_v).reshape(bsz, length, N_KV_HEADS, HEAD_DIM)
            h = h + _dilated_mixer(_rmsnorm(h, attn_norm_g[j]), w_q[j], w_o[j],
                                   k_shared, v_shared, cos, sin)
        h = h + _hier_moe(_rmsnorm(h, ffn_norm_g[i]), router_grp_w[i], router_grp_b[i],
                          router_exp_w[i], router_exp_b[i], w_gate[i], w_up[i], w_down[i])
        h = h + _per_layer_embedding(h, p[i], ple_norm_g[i], ple_gate_w[i], ple_proj_w[i])
    return _rmsnorm(h, final_norm_g)
```

```cpp
#include <hip/hip_runtime.h>
#include <cstdio>
#include <cstdint>

#define GAS __attribute__((address_space(1)))
#define LAS __attribute__((address_space(3)))
typedef unsigned short bf16;
typedef short bf16x8 __attribute__((ext_vector_type(8)));
typedef short s16x4 __attribute__((ext_vector_type(4)));
typedef float f32x2 __attribute__((ext_vector_type(2)));
typedef float f32x4 __attribute__((ext_vector_type(4)));
typedef float f32x16 __attribute__((ext_vector_type(16)));
typedef unsigned u32x2 __attribute__((ext_vector_type(2)));
typedef unsigned u32x4 __attribute__((ext_vector_type(4)));
typedef __bf16 bf16x2_t __attribute__((ext_vector_type(2)));

#ifndef MK_N_LAUNCHES
#define MK_N_LAUNCHES 1
#endif

constexpr int T = 16384, D = 2048, SEQ = 2048;
constexpr int NWAVES = 8, NTHR = 512;
constexpr int NPH = 20;
constexpr float EPS = 1e-6f;
constexpr int LDS_BYTES = 159744;

constexpr size_t MiB = 1u << 20;
constexpr size_t WS_CTL = 0, CTL_ZERO_BYTES = 1 * MiB;
constexpr size_t WS_ROPE = 1 * MiB;
constexpr size_t WS_S5B = 2 * MiB;
constexpr size_t WS_S5D = 2 * MiB + 512 * 1024;
constexpr size_t WS_LB = 2 * MiB + 768 * 1024;
constexpr size_t WS_S5C = 3 * MiB;
constexpr size_t WS_WR = 4 * MiB;
constexpr size_t WS_RSTAT = 5 * MiB;
constexpr size_t WS_PART = 6 * MiB;
constexpr size_t WS_LSE = 8 * MiB;
constexpr size_t WS_RINFO = 12 * MiB;
constexpr size_t WS_RW = 14 * MiB;
constexpr size_t WS_RR = 16 * MiB;
constexpr size_t WS_TOKREC = 18 * MiB;
constexpr size_t WS_PBF = 20 * MiB;
constexpr size_t WS_WGLU = 40 * MiB;
constexpr size_t WS_WQKV = 56 * MiB;
constexpr size_t WS_WO = 88 * MiB;
constexpr size_t WS_WPG = 96 * MiB;
constexpr size_t WS_WPP = 112 * MiB;
constexpr size_t WS_WGU = 116 * MiB;
constexpr size_t WS_WDN = 244 * MiB;
constexpr size_t WS_X = 308 * MiB;
constexpr size_t WS_U0 = WS_X, WS_G0 = WS_X + 64 * MiB;
constexpr size_t WS_SLOT = WS_X, WS_HID = WS_X + 128 * MiB;
constexpr size_t WS_Q = WS_X, WS_O = WS_X + 192 * MiB;
constexpr size_t WS_KB = 564 * MiB, WS_VB = 596 * MiB;
constexpr size_t WS_PP = 628 * MiB;
constexpr size_t WS_HA = 756 * MiB, WS_HB = 820 * MiB;
constexpr size_t WS_END = 884 * MiB;
constexpr int CW_BAR = 4096;
constexpr int CW_CNT = 16384;

__device__ __forceinline__ unsigned cvtpk(float lo, float hi) { f32x2 v = {lo, hi}; bf16x2_t b = __builtin_convertvector(v, bf16x2_t); return __builtin_bit_cast(unsigned, b); }
__device__ __forceinline__ float bflo(unsigned w) { return __uint_as_float(w << 16); }
__device__ __forceinline__ float bfhi(unsigned w) { return __uint_as_float(w & 0xffff0000u); }
__device__ __forceinline__ float wave_sum(float v) {
#pragma unroll
    for (int o = 1; o < 64; o <<= 1) v += __shfl_xor(v, o);
    return v;
}
__device__ __forceinline__ float sigmoidf_(float x) { return __builtin_amdgcn_rcpf(1.f + __builtin_amdgcn_exp2f(-1.4426950408889634f * x)); }
__device__ __forceinline__ float gelu_tanh(float x) { const float z = x * (2.3022082f + 0.1029432f * x * x); return x * __builtin_amdgcn_rcpf(1.f + __builtin_amdgcn_exp2f(-z)); }
#define LDS_WAIT() asm volatile("s_waitcnt lgkmcnt(0)" ::: "memory")

#define XB_TMO      128
#define XB_XCNT(j)  (256  + 64 * (j))
#define XB_XSUB(j)  (1280 + 64 * (j))
#define XB_XGEN(j)  (2304 + 64 * (j))
#define XB_TOP      3328
#define XB_TOPGEN   3392
#define XCD_BAR_WORDS 3456
#define XB_SPIN_CAP (1u << 18)
__device__ __forceinline__ unsigned xb_ld(unsigned* p)              { return __hip_atomic_load(p, __ATOMIC_RELAXED, __HIP_MEMORY_SCOPE_AGENT); }
__device__ __forceinline__ unsigned xb_add(unsigned* p, unsigned v) { return __hip_atomic_fetch_add(p, v, __ATOMIC_RELAXED, __HIP_MEMORY_SCOPE_AGENT); }
__device__ __forceinline__ unsigned xb_xcc_id() { return (unsigned)__builtin_amdgcn_s_getreg((3 << 11) | 20) & 0xFu; }
#define XB_SPIN(cond, bar) do { unsigned _sp = 0; while (cond) { __builtin_amdgcn_s_sleep(1); \
    if ((++_sp & 255u) == 0u) { if (xb_ld(&(bar)[XB_TMO])) break; if (_sp > XB_SPIN_CAP) { atomicAdd(&(bar)[XB_TMO], 1u); break; } } } } while (0)
struct XcdBarrier { unsigned* bar; unsigned x; volatile LAS unsigned* st; };
__device__ __forceinline__ XcdBarrier xcd_barrier_post(unsigned* bar, volatile LAS unsigned* st) {
    XcdBarrier b; b.bar = bar; b.x = xb_xcc_id(); b.st = st;
    if (threadIdx.x == 0) (void)xb_add(&bar[XB_XCNT(b.x)], 1u);
    return b;
}
__device__ __forceinline__ void xcd_barrier_complete(unsigned* bar, unsigned x, unsigned& nloc, unsigned& nx) {
    const unsigned G = gridDim.x * gridDim.y * gridDim.z;
    unsigned sum, cnt, mine, sp = 0u;
    for (;;) {
        sum = 0u; cnt = 0u; mine = 0u;
#pragma unroll
        for (unsigned j = 0; j < 16; ++j) { const unsigned c = xb_ld(&bar[XB_XCNT(j)]); sum += c; cnt += (c > 0u) ? 1u : 0u; mine = (j == x) ? c : mine; }
        if (sum == G) break;
        __builtin_amdgcn_s_sleep(1);
        if ((++sp & 255u) == 0u) { if (xb_ld(&bar[XB_TMO])) break; if (sp > XB_SPIN_CAP) { atomicAdd(&bar[XB_TMO], 1u); break; } }
    }
    nloc = mine > 0u ? mine : 1u; nx = cnt > 0u ? cnt : 1u;
}
__device__ __forceinline__ void xcd_barrier(const XcdBarrier& b) {
    asm volatile("s_waitcnt vmcnt(0)" ::: "memory");
    __syncthreads();
    if (threadIdx.x == 0) {
        unsigned* bar = b.bar;
        __builtin_amdgcn_s_waitcnt(0);
        unsigned nloc = b.st[0], nx = b.st[1];
        if (nloc == 0u) { xcd_barrier_complete(bar, b.x, nloc, nx); b.st[0] = nloc; b.st[1] = nx; }
        const unsigned old = xb_add(&bar[XB_XSUB(b.x)], 1u);
        const unsigned gen = old / nloc;
        if (old + 1u == (gen + 1u) * nloc) {
            __builtin_amdgcn_fence(__ATOMIC_RELEASE, "agent");
            asm volatile("s_waitcnt vmcnt(0)" ::: "memory");
            const unsigned og = xb_add(&bar[XB_TOP], 1u);
            const unsigned tg = og / nx;
            if (og + 1u == (tg + 1u) * nx) xb_add(&bar[XB_TOPGEN], 1u);
            else XB_SPIN(xb_ld(&bar[XB_TOPGEN]) == tg, bar);
            __builtin_amdgcn_fence(__ATOMIC_ACQUIRE, "agent");
            xb_add(&bar[XB_XGEN(b.x)], 1u);
            asm volatile("s_waitcnt vmcnt(0)" ::: "memory");
        } else {
            XB_SPIN(xb_ld(&bar[XB_XGEN(b.x)]) == gen, bar);
            __builtin_amdgcn_fence(__ATOMIC_ACQUIRE, "agent");
            asm volatile("s_waitcnt vmcnt(0)" ::: "memory");
        }
    }
    __syncthreads();
}

struct WUnit { const bf16* A; const bf16* B; const int* gidx; const int* info; int pm, pn, ex, nrows; };

namespace pg8 {
constexpr int BK = 64, HALF = 128, HTB = HALF * BK * 2, STAGE_BYTES = 8 * HTB;
__device__ __forceinline__ int lds_byte(int r, int c) { const int cc = c >> 3; return (r >> 3) * 1024 + ((((r & 7) << 3) | (cc ^ ((r >> 1) & 7))) << 4) + (c & 7) * 2; }
__device__ __forceinline__ void stage_rc(int b, int& R, int& C) { const int t = b >> 4, w = t >> 6, l = t & 63; R = 8 * w + (l >> 3); C = 8 * ((l & 7) ^ ((R >> 1) & 7)); }

template <bool GATHER>
__device__ __forceinline__ void unit_offsets(const WUnit& u, const int K, int R0, int C0, unsigned (&o)[2][2]) {
    if (GATHER) { int t = threadIdx.x; asm volatile("" : "+v"(t)); stage_rc(t * 16, R0, C0); }
#pragma unroll
    for (int h = 0; h < 2; ++h)
#pragma unroll
        for (int i = 0; i < 2; ++i) {
            int row = R0 + 64 * i + HALF * h;
            if (GATHER) row = (row < u.nrows) ? (u.gidx[row] >> 1) : 0;
            o[h][i] = ((unsigned)row * (unsigned)K + (unsigned)C0) * 2u;
        }
}

template <bool GATHER, bool ALIGN_EPI, bool FRESH_TID = false, class Epi, class Sched>
__device__ __forceinline__ void gemm_phase(LAS unsigned char* lds, const int K, const Sched& S, const Epi& E) {
    int tid_ = threadIdx.x; if (FRESH_TID) asm volatile("" : "+v"(tid_));
    const int tid = tid_, wid = __builtin_amdgcn_readfirstlane(tid >> 6), lane = tid & 63, wr = wid >> 2, wc = wid & 3, fr = lane & 15, fq = lane >> 4;
    const int nt = K / BK;
    int sR, sC; stage_rc(tid * 16, sR, sC);
    const int sRb = (sR & ~31) + (8 * ((sR & 15) >> 2) + 4 * ((sR >> 4) & 1) + (sR & 3));
    const unsigned voffB0 = (unsigned)(sRb * K + sC) * 2u; const unsigned r64 = 64u * (unsigned)K * 2u;
    const size_t kstep = (size_t)(BK * 2);
    const size_t hstep = (size_t)HALF * K * 2;
    const unsigned ldsw = (unsigned)wid * 1024u;
    const int aoff0 = lds_byte(wr * 64 + fr, fq * 8), boff0 = lds_byte(wc * 32 + fr, fq * 8);
#define PG8_SA(b, h) (((b) * 2 + (h)) * HTB)
#define PG8_SB(b, h) ((4 + (b) * 2 + (h)) * HTB)
#define PG8_STAGE_B(bufoff, gbase) do { \
        __builtin_amdgcn_global_load_lds((const unsigned*)((const char*)(gbase) + voffB0), (LAS unsigned*)(lds + (bufoff) + ldsw), 16, 0, 0); \
        __builtin_amdgcn_global_load_lds((const unsigned*)((const char*)(gbase) + r64 + voffB0), (LAS unsigned*)(lds + (bufoff) + ldsw + 8192), 16, 0, 0); } while (0)
#define PG8_STAGE_A(bufoff, gbase, o0, o1) do { \
        __builtin_amdgcn_global_load_lds((const unsigned*)((const char*)(gbase) + (o0)), (LAS unsigned*)(lds + (bufoff) + ldsw), 16, 0, 0); \
        __builtin_amdgcn_global_load_lds((const unsigned*)((const char*)(gbase) + (o1)), (LAS unsigned*)(lds + (bufoff) + ldsw + 8192), 16, 0, 0); } while (0)
#define PG8_LDA(dst, b, h) do { int aoff1; asm volatile("v_xor_b32 %0, 64, %1" : "=v"(aoff1) : "v"(aoff0)); _Pragma("unroll") for (int m = 0; m < 4; ++m) _Pragma("unroll") for (int k = 0; k < 2; ++k) dst[m][k] = *(const LAS bf16x8*)(lds + PG8_SA(b, h) + (k ? aoff1 : aoff0) + m * 2048); } while (0)
#define PG8_LDB(dst, b, h) do { int boff1; asm volatile("v_xor_b32 %0, 64, %1" : "=v"(boff1) : "v"(boff0)); _Pragma("unroll") for (int n = 0; n < 2; ++n) _Pragma("unroll") for (int k = 0; k < 2; ++k) dst[n][k] = *(const LAS bf16x8*)(lds + PG8_SB(b, h) + (k ? boff1 : boff0) + n * 2048); } while (0)
#define PG8_MMA(ai, bj, At, Bt) do { __builtin_amdgcn_s_setprio(1); _Pragma("unroll") for (int m = 0; m < 4; ++m) _Pragma("unroll") for (int n = 0; n < 2; ++n) _Pragma("unroll") for (int k = 0; k < 2; ++k) \
        acc[ai][bj][m][n] = __builtin_amdgcn_mfma_f32_16x16x32_bf16(Bt[n][k], At[m][k], acc[ai][bj][m][n], 0, 0, 0); __builtin_amdgcn_s_setprio(0); } while (0)
#define PG8_WAIT_V(n) asm volatile("s_waitcnt vmcnt(" #n ")" ::: "memory")
#define PG8_WAIT_L(n) asm volatile("s_waitcnt lgkmcnt(" #n ")" ::: "memory")
#define PG8_BAR __builtin_amdgcn_s_barrier()
#define PG8_SCHED __builtin_amdgcn_sched_barrier(0)
    WUnit cur, nxt; int ui = 0;
    if (!S.next(0, cur)) return;
    unsigned oc[2][2];
    LAS unsigned char* pk = lds + STAGE_BYTES + tid * 32;
    unit_offsets<GATHER>(cur, K, sR, sC, oc);
    if constexpr (GATHER) { u32x4 q; q.x = oc[0][0]; q.y = oc[0][1]; q.z = oc[1][0]; q.w = oc[1][1]; *(LAS u32x4*)pk = q; }
    f32x4 acc[2][2][4][2];
#pragma unroll
    for (int a = 0; a < 2; ++a)
#pragma unroll
        for (int b = 0; b < 2; ++b)
#pragma unroll
            for (int m = 0; m < 4; ++m)
#pragma unroll
                for (int n = 0; n < 2; ++n) acc[a][b][m][n] = (f32x4){0.f, 0.f, 0.f, 0.f};
    bf16x8 At[4][2], B0[2][2], B1[2][2];
    const char* cA = (const char*)cur.A; const char* cB = (const char*)cur.B;
    PG8_STAGE_B(PG8_SB(0, 0), cB); PG8_STAGE_B(PG8_SB(0, 1), cB + hstep); PG8_STAGE_A(PG8_SA(0, 0), cA, oc[0][0], oc[0][1]); PG8_STAGE_A(PG8_SA(0, 1), cA, oc[1][0], oc[1][1]);
    if (wr == 1) PG8_BAR;
    PG8_WAIT_V(2); PG8_BAR;
    PG8_STAGE_B(PG8_SB(1, 0), cB + kstep); PG8_STAGE_A(PG8_SA(1, 0), cA + kstep, oc[0][0], oc[0][1]); PG8_STAGE_B(PG8_SB(1, 1), cB + hstep + kstep);
    PG8_WAIT_V(6); PG8_BAR;
    for (;;) {
        const bool has_next = S.next(ui + 1, nxt);
        const char* nA = has_next ? (const char*)nxt.A : cA; const char* nB = has_next ? (const char*)nxt.B : cB;
        if constexpr (GATHER) {
            unsigned on[2][2];
            if (has_next) unit_offsets<true>(nxt, K, sR, sC, on);
            else { const u32x4 q = *(const LAS u32x4*)pk; on[0][0] = q.x; on[0][1] = q.y; on[1][0] = q.z; on[1][1] = q.w; }
            u32x4 q; q.x = on[0][0]; q.y = on[0][1]; q.z = on[1][0]; q.w = on[1][1]; *(LAS u32x4*)(pk + 16) = q;
        }
#pragma clang loop unroll(disable)
        for (int t = 0; t < nt; t += 2) {
            const bool last = (t == nt - 2);
            const char* a1 = cA + (size_t)(t + 1) * kstep;
            const char* a2 = last ? nA : cA + (size_t)(t + 2) * kstep; const char* b2 = last ? nB : cB + (size_t)(t + 2) * kstep;
            const char* a3 = a2 + kstep; const char* b3 = b2 + kstep;
            const int nsel = (GATHER && last) ? 16 : 0;
#define PG8_OFF(h, base) (GATHER ? *(const LAS u32x2*)(pk + (base) + 8 * (h)) : (u32x2){oc[h][0], oc[h][1]})
            { const u32x2 o = PG8_OFF(1, 0);
              PG8_LDB(B0, 0, 0); PG8_LDB(B1, 0, 1); PG8_SCHED; PG8_LDA(At, 0, 0); PG8_STAGE_A(PG8_SA(1, 1), a1, o.x, o.y); }
            PG8_WAIT_V(8); PG8_WAIT_L(0); PG8_BAR; PG8_MMA(0, 0, At, B0); PG8_MMA(0, 1, At, B1); PG8_BAR; PG8_SCHED;
            { const u32x2 o = PG8_OFF(0, nsel);
              PG8_LDA(At, 0, 1); PG8_STAGE_B(PG8_SB(0, 0), b2); PG8_STAGE_B(PG8_SB(0, 1), b2 + hstep); PG8_STAGE_A(PG8_SA(0, 0), a2, o.x, o.y); }
            PG8_WAIT_V(8); PG8_WAIT_L(0); PG8_BAR; PG8_MMA(1, 0, At, B0); PG8_MMA(1, 1, At, B1); PG8_BAR; PG8_SCHED;
            { const u32x2 o = PG8_OFF(1, nsel);
              PG8_LDB(B0, 1, 0); PG8_LDB(B1, 1, 1); PG8_SCHED; PG8_LDA(At, 1, 0); PG8_STAGE_A(PG8_SA(0, 1), a2, o.x, o.y); }
            PG8_WAIT_V(8); PG8_WAIT_L(0); PG8_BAR; PG8_MMA(0, 0, At, B0); PG8_MMA(0, 1, At, B1); PG8_BAR; PG8_SCHED;
            { const u32x2 o = PG8_OFF(0, nsel);
              PG8_LDA(At, 1, 1); PG8_STAGE_B(PG8_SB(1, 0), b3); PG8_STAGE_B(PG8_SB(1, 1), b3 + hstep); PG8_STAGE_A(PG8_SA(1, 0), a3, o.x, o.y); }
            PG8_WAIT_V(8); PG8_WAIT_L(0); PG8_BAR; PG8_MMA(1, 0, At, B0); PG8_MMA(1, 1, At, B1); PG8_BAR; PG8_SCHED;
#undef PG8_OFF
        }
        if constexpr (ALIGN_EPI) { if (wr == 0) PG8_BAR; }
        { int fr_ = fr, fq_ = fq; asm volatile("" : "+v"(fr_), "+v"(fq_));
          E(acc, cur, wr, wc, fr_, fq_); }
        if (!has_next) break;
#pragma unroll
        for (int a = 0; a < 2; ++a)
#pragma unroll
            for (int b = 0; b < 2; ++b)
#pragma unroll
                for (int m = 0; m < 4; ++m)
#pragma unroll
                    for (int n = 0; n < 2; ++n) acc[a][b][m][n] = (f32x4){0.f, 0.f, 0.f, 0.f};
        cur = nxt; cA = nA; cB = nB; ++ui;
        if constexpr (GATHER) { const u32x4 q = *(const LAS u32x4*)(pk + 16); *(LAS u32x4*)pk = q; }
        if constexpr (ALIGN_EPI) { if (wr == 1) PG8_BAR; }
    }
    PG8_WAIT_V(0);
    if constexpr (!ALIGN_EPI) { if (wr == 0) PG8_BAR; }
    PG8_BAR;
#undef PG8_SA
#undef PG8_SB
#undef PG8_STAGE_A
#undef PG8_STAGE_B
#undef PG8_LDA
#undef PG8_LDB
#undef PG8_MMA
#undef PG8_WAIT_V
#undef PG8_WAIT_L
#undef PG8_BAR
#undef PG8_SCHED
}
}

struct DenseSched {
    const bf16* A; const bf16* B; int K, nM, nN, G, c;
    __device__ __forceinline__ bool next(int i, WUnit& u) const {
        const int nwg = nM * nN; const int Lx = i * G + c; if (Lx >= nwg) return false;
        int wgid = Lx; { const int q = nwg / 8, r = nwg % 8, xcd = wgid % 8, off = wgid / 8; wgid = (xcd < r ? xcd * (q + 1) : r * (q + 1) + (xcd - r) * q) + off; }
        const int nig = 4 * nN, gid = wgid / nig, fm = gid * 4, gsz = (nM - fm) < 4 ? (nM - fm) : 4;
        u.pm = fm + ((wgid % nig) % gsz); u.pn = (wgid % nig) / gsz;
        u.A = A + (size_t)u.pm * 256 * K; u.B = B + (size_t)u.pn * 256 * K; u.gidx = nullptr; u.info = nullptr; u.ex = 0; u.nrows = 256; return true;
    }
};
struct FillSched {
    const bf16* A; const bf16* B; int K, nM, nN, G, c, R;
    __device__ __forceinline__ bool next(int i, WUnit& u) const {
        const int Gp = G - R; if (c < R || Gp <= 0) return false;
        const int nwg = nM * nN; const int Lx = i * Gp + (c - R); if (Lx >= nwg) return false;
        u.pm = Lx / nN; u.pn = Lx - u.pm * nN;
        u.A = A + (size_t)u.pm * 256 * K; u.B = B + (size_t)u.pn * 256 * K; u.gidx = nullptr; u.info = nullptr; u.ex = 0; u.nrows = 256; return true;
    }
};
struct MoeSched {
    const bf16* A; const bf16* Bw; const int* rowinfo; const LAS int* pre; int K, NPN, G, c; size_t bstride; bool gather;
    __device__ __forceinline__ bool next(int i, WUnit& u) const {
        const int tot = pre[32] * NPN; int Lx = i * G + c; if (Lx >= tot) return false;
        { const int q = tot / 8, r = tot % 8, xcd = Lx % 8, off = Lx / 8; Lx = (xcd < r ? xcd * (q + 1) : r * (q + 1) + (xcd - r) * q) + off; }
        const int gm = Lx / NPN; u.pn = Lx - gm * NPN; int e = 0;
        for (int j = 1; j < 32; ++j) e += (pre[j] <= gm) ? 1 : 0;
        u.ex = e; const int mt = gm - pre[e]; u.pm = gm; const int ne = pre[40 + e]; const int left = ne - 256 * mt; u.nrows = left < 256 ? left : 256;
        u.B = Bw + (size_t)e * bstride + (size_t)u.pn * 256 * K;
        u.info = rowinfo + (size_t)e * T + 256 * mt;
        if (gather) { u.A = A; u.gidx = u.info; } else { u.A = A + (size_t)gm * 256 * K; u.gidx = nullptr; }
        return true;
    }
};

#define EPI_LOOP _Pragma("unroll") for (int ai = 0; ai < 2; ++ai) _Pragma("unroll") for (int m = 0; m < 4; ++m) _Pragma("unroll") for (int n = 0; n < 2; ++n)
#define EPI_RC const int r = 128 * ai + 64 * wr + 16 * m + fr; const int c = 32 * wc + 16 * n + 4 * fq;
typedef f32x4 AccT[2][2][4][2];

#ifndef EPI_SC1
#define EPI_SC1 0
#endif
__device__ __forceinline__ void st16(bf16* base, size_t elem, const u32x4 v) {
#if EPI_SC1
    const __amdgpu_buffer_rsrc_t r = __builtin_amdgcn_make_buffer_rsrc(base, 0, 0x7fffffff, 0x00020000);
    __builtin_amdgcn_raw_buffer_store_b128(v, r, (int)(unsigned)(elem * 2), 0, 16);
#else
    *(u32x4*)(base + elem) = v;
#endif
}
__device__ __forceinline__ u32x4 pack8(const f32x4 a, const f32x4 b) { u32x4 w; w.x = cvtpk(a[0], a[1]); w.y = cvtpk(a[2], a[3]); w.z = cvtpk(b[0], b[1]); w.w = cvtpk(b[2], b[3]); return w; }
__device__ __forceinline__ void unpack8(const u32x4 w, f32x4& a, f32x4& b) { a[0] = bflo(w.x); a[1] = bfhi(w.x); a[2] = bflo(w.y); a[3] = bfhi(w.y); b[0] = bflo(w.z); b[1] = bfhi(w.z); b[2] = bflo(w.w); b[3] = bfhi(w.w); }
struct EpiGLU {
    const float* x; const float* bias; bf16* out;
    __device__ __forceinline__ void operator()(const AccT& acc, const WUnit& u, int wr, int wc, int fr, int fq) const {
        const int col = 128 * u.pn + 32 * wc + 8 * fq;
        f32x4 bv[2], bg[2];
#pragma unroll
        for (int n = 0; n < 2; ++n) { bv[n] = *(const f32x4*)(bias + col + 4 * n); bg[n] = *(const f32x4*)(bias + 2048 + col + 4 * n); }
#pragma unroll
        for (int ai = 0; ai < 2; ++ai) {
            f32x4 xv[4][2];
#pragma unroll
            for (int m = 0; m < 4; ++m)
#pragma unroll
                for (int n = 0; n < 2; ++n) xv[m][n] = *(const f32x4*)(x + ((size_t)u.pm * 256 + 128 * ai + 64 * wr + 16 * m + fr) * D + col + 4 * n);
#pragma unroll
            for (int m = 0; m < 4; ++m) { const size_t row = (size_t)u.pm * 256 + 128 * ai + 64 * wr + 16 * m + fr; f32x4 o[2];
#pragma unroll
                for (int n = 0; n < 2; ++n) { const f32x4 v = acc[ai][0][m][n] + bv[n], g = acc[ai][1][m][n] + bg[n];
#pragma unroll
                    for (int i = 0; i < 4; ++i) o[n][i] = xv[m][n][i] + v[i] * sigmoidf_(g[i]); }
                st16(out, row * D + col, pack8(o[0], o[1])); }
        }
    }
};
struct EpiStore {
    bf16* out; int ldc;
    __device__ __forceinline__ void operator()(const AccT& acc, const WUnit& u, int wr, int wc, int fr, int fq) const {
#pragma unroll
        for (int ai = 0; ai < 2; ++ai)
#pragma unroll
            for (int m = 0; m < 4; ++m) { const size_t row = (size_t)u.pm * 256 + 128 * ai + 64 * wr + 16 * m + fr;
#pragma unroll
                for (int bj = 0; bj < 2; ++bj) st16(out, row * ldc + 256 * u.pn + 128 * bj + 32 * wc + 8 * fq, pack8(acc[ai][bj][m][0], acc[ai][bj][m][1])); }
    }
};
struct EpiGateUp {
    const float* rr; const float* rw; bf16* hid; const int* rinfo0;
    __device__ __forceinline__ void operator()(const AccT& acc, const WUnit& u, int wr, int wc, int fr, int fq) const {
        const size_t lbase = (size_t)(u.info - rinfo0);
#pragma unroll
        for (int ai = 0; ai < 2; ++ai)
#pragma unroll
            for (int mp = 0; mp < 2; ++mp) {
                float sr[2], sw[2];
#pragma unroll
                for (int mm = 0; mm < 2; ++mm) { const int r = 128 * ai + 64 * wr + 16 * (2 * mp + mm) + fr; const bool ok = r < u.nrows; sr[mm] = ok ? rr[lbase + r] : 0.f; sw[mm] = ok ? rw[lbase + r] : 0.f; }
#pragma unroll
                for (int mm = 0; mm < 2; ++mm) { const int m = 2 * mp + mm; const int r = 128 * ai + 64 * wr + 16 * m + fr; f32x4 o[2];
#pragma unroll
                    for (int n = 0; n < 2; ++n) { const f32x4 g = acc[ai][0][m][n] * sr[mm], up = acc[ai][1][m][n] * sr[mm];
#pragma unroll
                        for (int i = 0; i < 4; ++i) o[n][i] = (g[i] * sigmoidf_(g[i])) * up[i] * sw[mm]; }
                    st16(hid, ((size_t)u.pm * 256 + r) * 512 + 128 * u.pn + 32 * wc + 8 * fq, pack8(o[0], o[1])); }
            }
    }
};
struct EpiDown {
    bf16* slot;
    __device__ __forceinline__ void operator()(const AccT& acc, const WUnit& u, int wr, int wc, int fr, int fq) const {
        int inf[2][4];
#pragma unroll
        for (int ai = 0; ai < 2; ++ai)
#pragma unroll
            for (int m = 0; m < 4; ++m) { const int r = 128 * ai + 64 * wr + 16 * m + fr; inf[ai][m] = (r < u.nrows) ? u.info[r] : -1; }
#pragma unroll
        for (int ai = 0; ai < 2; ++ai)
#pragma unroll
            for (int m = 0; m < 4; ++m) { const int info = inf[ai][m];
                if (info >= 0) { const size_t tok = (size_t)(info >> 1), sl = (size_t)(info & 1);
                    const size_t o = (sl * T + tok) * D + 256 * u.pn + 32 * wc + 8 * fq;
#pragma unroll
                    for (int bj = 0; bj < 2; ++bj) st16(slot, o + 128 * bj, pack8(acc[ai][bj][m][0], acc[ai][bj][m][1])); } }
    }
};
struct EpiPLE {
    const bf16* hin; const bf16* pp; const float* rs; bf16* hout; float* part;
    __device__ __forceinline__ void operator()(const AccT& acc, const WUnit& u, int wr, int wc, int fr, int fq) const {
#pragma unroll
        for (int ai = 0; ai < 2; ++ai) {
            u32x4 hv[4][2], pv[4][2]; float sr[4];
#pragma unroll
            for (int m = 0; m < 4; ++m) { const size_t row = (size_t)u.pm * 256 + 128 * ai + 64 * wr + 16 * m + fr; sr[m] = rs[row];
#pragma unroll
                for (int bj = 0; bj < 2; ++bj) { const int col = 256 * u.pn + 128 * bj + 32 * wc + 8 * fq;
                    hv[m][bj] = *(const u32x4*)(hin + row * D + col); pv[m][bj] = *(const u32x4*)(pp + row * D + col); } }
#pragma unroll
            for (int m = 0; m < 4; ++m) { const size_t row = (size_t)u.pm * 256 + 128 * ai + 64 * wr + 16 * m + fr; float ss = 0.f;
#pragma unroll
                for (int bj = 0; bj < 2; ++bj) { const int col = 256 * u.pn + 128 * bj + 32 * wc + 8 * fq;
                    f32x4 h[2], p[2], o[2]; unpack8(hv[m][bj], h[0], h[1]); unpack8(pv[m][bj], p[0], p[1]);
#pragma unroll
                    for (int n = 0; n < 2; ++n) { const f32x4 av = acc[ai][bj][m][n];
#pragma unroll
                        for (int i = 0; i < 4; ++i) { o[n][i] = h[n][i] + sigmoidf_(sr[m] * av[i]) * p[n][i]; ss += o[n][i] * o[n][i]; } }
                    st16(hout, row * D + col, pack8(o[0], o[1])); }
                ss += __shfl_xor(ss, 16); ss += __shfl_xor(ss, 32);
                if (fq == 0) part[row * 32 + 4 * u.pn + wc] = ss; }
        }
    }
};
struct EpiQKV {
    const float* part; const float* rope; bf16* q; bf16* kb; bf16* vb;
    __device__ __forceinline__ void operator()(const AccT& acc, const WUnit& u, int wr, int wc, int fr, int fq) const {
        const bool rot = u.pn < 28;
        const int c = 32 * wc + 8 * fq, hsel = c >> 6, d = c & 63;
        const unsigned* rp = (const unsigned*)rope;
#pragma unroll
        for (int ai = 0; ai < 2; ++ai) {
            f32x4 p0[4], p1[4]; u32x4 cs[4][2];
#pragma unroll
            for (int m = 0; m < 4; ++m) { const size_t row = (size_t)u.pm * 256 + 128 * ai + 64 * wr + 16 * m + fr; const int pos = (int)(row & (SEQ - 1));
                p0[m] = *(const f32x4*)(part + row * 32 + 8 * fq); p1[m] = *(const f32x4*)(part + row * 32 + 8 * fq + 4);
                if (rot) { cs[m][0] = *(const u32x4*)(rp + (size_t)pos * 64 + d); cs[m][1] = *(const u32x4*)(rp + (size_t)pos * 64 + d + 4); }
                else { cs[m][0] = (u32x4){0x3f80u, 0x3f80u, 0x3f80u, 0x3f80u}; cs[m][1] = cs[m][0]; } }
#pragma unroll
            for (int m = 0; m < 4; ++m) { const size_t row = (size_t)u.pm * 256 + 128 * ai + 64 * wr + 16 * m + fr;
                float ss = ((p0[m][0] + p0[m][1]) + (p0[m][2] + p0[m][3])) + ((p1[m][0] + p1[m][1]) + (p1[m][2] + p1[m][3]));
                ss += __shfl_xor(ss, 16); ss += __shfl_xor(ss, 32);
                const float sr = rsqrtf(ss * (1.f / D) + EPS);
                f32x4 o1[2], o2[2];
#pragma unroll
                for (int n = 0; n < 2; ++n) { const f32x4 a1 = acc[ai][0][m][n] * sr, a2 = acc[ai][1][m][n] * sr;
                    if (rot) {
#pragma unroll
                        for (int i = 0; i < 4; ++i) { const unsigned w = cs[m][n][i]; const float co = bflo(w), si = bfhi(w); o1[n][i] = a1[i] * co - a2[i] * si; o2[n][i] = a2[i] * co + a1[i] * si; }
                    } else { o1[n] = a1; o2[n] = a2; } }
                if (u.pn < 24) { const size_t o = row * 6144 + (size_t)(2 * u.pn + hsel) * 128 + d; st16(q, o, pack8(o1[0], o1[1])); st16(q, o + 64, pack8(o2[0], o2[1])); }
                else if (rot) { const size_t o = row * 1024 + (size_t)(2 * (u.pn - 24) + hsel) * 128 + d; st16(kb, o, pack8(o1[0], o1[1])); st16(kb, o + 64, pack8(o2[0], o2[1])); }
                else { const size_t o = row * 1024 + 256 * (u.pn - 28) + c; st16(vb, o, pack8(o1[0], o1[1])); st16(vb, o + 128, pack8(o2[0], o2[1])); }
            }
        }
    }
};
struct EpiResAdd {
    const bf16* hin; bf16* hout;
    __device__ __forceinline__ void operator()(const AccT& acc, const WUnit& u, int wr, int wc, int fr, int fq) const {
        u32x4 hv[2][4][2];
#pragma unroll
        for (int ai = 0; ai < 2; ++ai)
#pragma unroll
            for (int m = 0; m < 4; ++m)
#pragma unroll
                for (int bj = 0; bj < 2; ++bj) hv[ai][m][bj] = *(const u32x4*)(hin + ((size_t)u.pm * 256 + 128 * ai + 64 * wr + 16 * m + fr) * D + 256 * u.pn + 128 * bj + 32 * wc + 8 * fq);
#pragma unroll
        for (int ai = 0; ai < 2; ++ai)
#pragma unroll
            for (int m = 0; m < 4; ++m) { const size_t row = (size_t)u.pm * 256 + 128 * ai + 64 * wr + 16 * m + fr;
#pragma unroll
                for (int bj = 0; bj < 2; ++bj) { f32x4 h[2]; unpack8(hv[ai][m][bj], h[0], h[1]);
                    st16(hout, row * D + 256 * u.pn + 128 * bj + 32 * wc + 8 * fq, pack8(h[0] + acc[ai][bj][m][0], h[1] + acc[ai][bj][m][1])); } }
    }
};

struct Args { const float* in[31]; float* out; unsigned char* ws; int ph_lo, ph_hi; };

struct TrDesc { const float* W; bf16* dst; const float* gain; int ldn, k0, n0, K, drow0; float scale; };
enum { MAP_PLAIN = 0, MAP_HALF0 = 1, MAP_HALF1 = 2, MAP_ROPE = 3 };
__device__ __forceinline__ int map_row(int mode, int n0) {
    if (mode == MAP_PLAIN) return n0;
    if (mode == MAP_HALF0) return 256 * (n0 >> 7) + (n0 & 127);
    if (mode == MAP_HALF1) return 256 * (n0 >> 7) + 128 + (n0 & 127);
    const int head = n0 >> 7, d = n0 & 127; return 256 * (head >> 1) + 128 * (d >> 6) + 64 * (head & 1) + (d & 63);
}
__device__ __forceinline__ TrDesc mk_desc(const float* W, int ldn, int K, int ncols, bf16* dst, int drow_base, int mode, const float* gain, float scale, int it) {
    const int nblk = ncols >> 6; const int kb = it / nblk, nb = it - kb * nblk;
    TrDesc d; d.W = W; d.dst = dst; d.gain = gain; d.ldn = ldn; d.k0 = 64 * kb; d.n0 = 64 * nb; d.K = K; d.drow0 = drow_base + map_row(mode, 64 * nb); d.scale = scale; return d;
}
__device__ __forceinline__ void tr_load(const TrDesc& d, f32x4 (&v)[16], int lane) {
    const int kq = lane >> 4, n4 = lane & 15;
#pragma unroll
    for (int j = 0; j < 16; ++j) v[j] = __builtin_nontemporal_load((const f32x4*)(d.W + (size_t)(d.k0 + kq + 4 * j) * d.ldn + d.n0 + 4 * n4));
}
__device__ __forceinline__ void tr_finish(const TrDesc& d, const f32x4 (&v)[16], LAS unsigned char* scr, int lane) {
    const int kq = lane >> 4, n4 = lane & 15;
#pragma unroll
    for (int j = 0; j < 16; ++j) { float g = d.scale; if (d.gain) g *= d.gain[d.k0 + kq + 4 * j];
        u32x2 w; w.x = cvtpk(v[j][0] * g, v[j][1] * g); w.y = cvtpk(v[j][2] * g, v[j][3] * g);
        *(LAS u32x2*)(scr + (kq + 4 * j) * 192 + n4 * 8) = w; }
    LDS_WAIT();
    const int G4 = lane >> 4, li = lane & 15, q = li >> 2, p = li & 3;
    u32x2 t[16];
#pragma unroll
    for (int r = 0; r < 16; ++r) t[r] = __builtin_bit_cast(u32x2, __builtin_amdgcn_ds_read_tr16_b64_v4i16((LAS s16x4*)(scr + (4 * r + q) * 192 + (16 * G4 + 4 * p) * 2)));
    bf16* o = d.dst + (size_t)(d.drow0 + 16 * G4 + li) * d.K + d.k0;
#pragma unroll
    for (int c = 0; c < 8; ++c) { u32x4 w; w.x = t[2 * c].x; w.y = t[2 * c].y; w.z = t[2 * c + 1].x; w.w = t[2 * c + 1].y; *(u32x4*)(o + 8 * c) = w; }
    LDS_WAIT();
}
struct MoeItems {
    const float* wg; const float* wu; const float* wd; const float* gain; bf16* WGU; bf16* WDN;
    __device__ __forceinline__ int count() const { return 32 * 768; }
    __device__ __forceinline__ TrDesc operator()(int it) const {
        const int e = it / 768, rem = it - e * 768, kind = rem >> 8, sub = rem & 255;
        if (kind == 0)      return mk_desc(wg + (size_t)e * 2048 * 512, 512, 2048, 512, WGU + (size_t)e * 1024 * 2048, 0, MAP_HALF0, gain, 1.f, sub);
        else if (kind == 1) return mk_desc(wu + (size_t)e * 2048 * 512, 512, 2048, 512, WGU + (size_t)e * 1024 * 2048, 0, MAP_HALF1, gain, 1.f, sub);
        return mk_desc(wd + (size_t)e * 512 * 2048, 2048, 512, 2048, WDN + (size_t)e * 2048 * 512, 0, MAP_PLAIN, nullptr, 1.f, sub);
    }
};
struct DenseItems {
    const Args* a; unsigned char* ws;
    __device__ __forceinline__ int count() const { return 9472; }
    __device__ __forceinline__ TrDesc operator()(int it) const {
        const float* const* in = a->in;
        bf16* WGLU = (bf16*)(ws + WS_WGLU); bf16* WQKV = (bf16*)(ws + WS_WQKV); bf16* WO = (bf16*)(ws + WS_WO); bf16* WPG = (bf16*)(ws + WS_WPG); bf16* WPP = (bf16*)(ws + WS_WPP);
        if (it < 1024) return mk_desc(in[11], 4096, 2048, 2048, WGLU, 0, MAP_HALF0, nullptr, 1.f, it); it -= 1024;
        if (it < 1024) return mk_desc(in[11] + 2048, 4096, 2048, 2048, WGLU, 0, MAP_HALF1, nullptr, 1.f, it); it -= 1024;
        if (it < 3072) return mk_desc(in[17], 6144, 2048, 6144, WQKV, 0, MAP_ROPE, in[16], 0.08838834764831845f, it); it -= 3072;
        if (it < 512) return mk_desc(in[14], 1024, 2048, 1024, WQKV, 6144, MAP_ROPE, in[13], 1.f, it); it -= 512;
        if (it < 512) return mk_desc(in[15], 1024, 2048, 1024, WQKV, 7168, MAP_PLAIN, in[13], 1.f, it); it -= 512;
        if (it < 1024) return mk_desc(in[18], 2048, 2048, 2048, WO, 0, MAP_PLAIN, nullptr, 1.f, it); it -= 1024;
        if (it < 1024) return mk_desc(in[28], 2048, 2048, 2048, WPG, 0, MAP_PLAIN, in[27], 1.f, it); it -= 1024;
        if (it < 128) return mk_desc(in[29], 2048, 256, 2048, WPP, 0, MAP_PLAIN, nullptr, 1.f, it); it -= 128;
        if (it < 1024) return mk_desc(in[28] + (size_t)2048 * 2048, 2048, 2048, 2048, WPG + (size_t)2048 * 2048, 0, MAP_PLAIN, in[27] + D, 1.f, it); it -= 1024;
        return mk_desc(in[29] + (size_t)256 * 2048, 2048, 256, 2048, WPP + (size_t)2048 * 256, 0, MAP_PLAIN, nullptr, 1.f, it);
    }
};
template <class Items>
__device__ __forceinline__ void run_items(const Items& I, int gw, int NGW, LAS unsigned char* scr, int lane) {
    const int n = I.count(); int it = gw; if (it >= n) return;
    TrDesc cur = I(it); f32x4 v[16]; tr_load(cur, v, lane);
    for (;;) {
        const int nx = it + NGW; const bool more = nx < n;
        TrDesc nd = cur; f32x4 w[16];
        if (more) { nd = I(nx); tr_load(nd, w, lane); }
        tr_finish(cur, v, scr, lane);
        if (!more) break;
#pragma unroll
        for (int j = 0; j < 16; ++j) v[j] = w[j];
        cur = nd; it = nx;
    }
}
__device__ __forceinline__ void moe_weights(const Args& a, int layer, int gw, int NGW, LAS unsigned char* scr, int lane) {
    MoeItems I{a.in[24] + (size_t)layer * 32 * 2048 * 512, a.in[25] + (size_t)layer * 32 * 2048 * 512, a.in[26] + (size_t)layer * 32 * 512 * 2048, a.in[19] + layer * D, (bf16*)(a.ws + WS_WGU), (bf16*)(a.ws + WS_WDN)};
    run_items(I, gw, NGW, scr, lane);
}

__device__ __forceinline__ void p0_prologue(const Args& a, LAS unsigned char* lds, int vcu, int G) {
    const int tid = threadIdx.x, lane = tid & 63, wave = __builtin_amdgcn_readfirstlane(tid >> 6);
    LAS unsigned char* scr = lds + wave * 16384;
    const int gw = vcu * NWAVES + wave, NGW = G * NWAVES;
    unsigned char* ws = a.ws;
    { DenseItems I{&a, ws}; run_items(I, gw, NGW, scr, lane); }
    {
        const float* x = a.in[0]; const float* g = a.in[2]; bf16* U0 = (bf16*)(ws + WS_U0);
        for (int row = gw; row < T; row += NGW) {
            const float* xr = x + (size_t)row * D; f32x4 v[4][2]; float ss = 0.f;
#pragma unroll
            for (int j = 0; j < 4; ++j) { v[j][0] = __builtin_nontemporal_load((const f32x4*)(xr + j * 512 + lane * 8)); v[j][1] = __builtin_nontemporal_load((const f32x4*)(xr + j * 512 + lane * 8 + 4));
#pragma unroll
                for (int h = 0; h < 2; ++h) ss += (v[j][h][0] * v[j][h][0] + v[j][h][1] * v[j][h][1]) + (v[j][h][2] * v[j][h][2] + v[j][h][3] * v[j][h][3]); }
            const float r = rsqrtf(wave_sum(ss) * (1.f / D) + EPS);
#pragma unroll
            for (int j = 0; j < 4; ++j) { const f32x4 g0 = *(const f32x4*)(g + j * 512 + lane * 8), g1 = *(const f32x4*)(g + j * 512 + lane * 8 + 4);
                u32x4 w; w.x = cvtpk(v[j][0][0] * r * g0[0], v[j][0][1] * r * g0[1]); w.y = cvtpk(v[j][0][2] * r * g0[2], v[j][0][3] * r * g0[3]);
                w.z = cvtpk(v[j][1][0] * r * g1[0], v[j][1][1] * r * g1[1]); w.w = cvtpk(v[j][1][2] * r * g1[2], v[j][1][3] * r * g1[3]);
                *(u32x4*)(U0 + (size_t)row * D + j * 512 + lane * 8) = w; }
        }
    }
    const int gt = vcu * NTHR + tid, NGT = G * NTHR;
    {
        const float* p = a.in[1]; bf16* PB = (bf16*)(ws + WS_PBF);
        for (int i = gt; i < 2 * T * 256 / 8; i += NGT) { const f32x4 v0 = __builtin_nontemporal_load((const f32x4*)(p + (size_t)i * 8)), v1 = __builtin_nontemporal_load((const f32x4*)(p + (size_t)i * 8 + 4));
            u32x4 w; w.x = cvtpk(v0[0], v0[1]); w.y = cvtpk(v0[2], v0[3]); w.z = cvtpk(v1[0], v1[1]); w.w = cvtpk(v1[2], v1[3]); *(u32x4*)(PB + (size_t)i * 8) = w; }
    }
    {
        float* rope = (float*)(ws + WS_ROPE);
        for (int i = gt; i < SEQ * 64; i += NGT) { const int pos = i >> 6, d = i & 63;
            const float inv = __builtin_amdgcn_exp2f(-(float)d * (13.287712379549449f / 64.f));
            float xrev = (float)pos * inv * 0.15915494309189535f; xrev -= floorf(xrev);
            ((unsigned*)rope)[i] = cvtpk(__builtin_amdgcn_cosf(xrev), __builtin_amdgcn_sinf(xrev)); }
    }
    {
        bf16* S5B = (bf16*)(ws + WS_S5B); bf16* S5C = (bf16*)(ws + WS_S5C); float* LB = (float*)(ws + WS_LB);
        for (int i = gt; i < 128 * 64; i += NGT) { const int g = i >> 6, p = i & 63;
            const float are = a.in[3][i], aim = a.in[4][i], dt = __expf(a.in[5][g]);
            const float mag = __expf(are * dt); float xrev = aim * dt * 0.15915494309189535f; xrev -= floorf(xrev);
            const float lre = mag * __builtin_amdgcn_cosf(xrev), lim = mag * __builtin_amdgcn_sinf(xrev);
            LB[2 * i] = lre; LB[2 * i + 1] = lim;
            const float nre = lre - 1.f, nim = lim, den = 1.f / (are * are + aim * aim);
            const float cre = (nre * are + nim * aim) * den, cim = (nim * are - nre * aim) * den;
            for (int ch = 0; ch < 16; ++ch) { const float bre = a.in[6][(size_t)i * 16 + ch], bim = a.in[7][(size_t)i * 16 + ch];
                const float vre = cre * bre - cim * bim, vim = cre * bim + cim * bre;
                const int hi = ch >> 3, jj = ch & 7;
#pragma unroll
                for (int ri = 0; ri < 2; ++ri) { const int col = 2 * p + ri, j = col >> 5, ln = (col & 31) + 32 * hi;
                    S5B[(((size_t)g * 4 + j) * 64 + ln) * 8 + jj] = (bf16)(cvtpk(ri ? vim : vre, 0.f) & 0xffffu); } }
#pragma unroll
            for (int ri = 0; ri < 2; ++ri) { const int k = 2 * p + ri, kk = k >> 4, hi = (k >> 3) & 1, jj = k & 7;
                for (int n = 0; n < 32; ++n) { float v = 0.f; if (n < 16) v = ri ? -a.in[9][((size_t)g * 16 + n) * 64 + p] : a.in[8][((size_t)g * 16 + n) * 64 + p];
                    S5C[(((size_t)g * 8 + kk) * 64 + (n + 32 * hi)) * 8 + jj] = (bf16)(cvtpk(v, 0.f) & 0xffffu); } }
        }
        bf16* S5D = (bf16*)(ws + WS_S5D);
        for (int i = gt; i < 128 * 64; i += NGT) { const int g = i >> 6, ln = i & 63, n = ln & 31, hi = ln >> 5;
#pragma unroll
            for (int jj = 0; jj < 8; ++jj) { const int k = 8 * hi + jj; const float v = (n == k && n < 16) ? a.in[10][g * 16 + n] : 0.f; S5D[(size_t)i * 8 + jj] = (bf16)(cvtpk(v, 0.f) & 0xffffu); } }
    }
    {
        bf16* WR = (bf16*)(ws + WS_WR);
        for (int i = gt; i < 2 * 48 * 2048; i += NGT) { const int l = i / (48 * 2048), rem = i - l * 48 * 2048, n = rem >> 11, k = rem & 2047;
            float w = 0.f; if (n < 4) w = a.in[20][((size_t)l * 2048 + k) * 4 + n]; else if (n < 36) w = a.in[22][((size_t)l * 2048 + k) * 32 + (n - 4)];
            w *= a.in[19][l * D + k];
            const unsigned hi = cvtpk(w, 0.f) & 0xffffu; const float lo = w - __uint_as_float(hi << 16);
            WR[((size_t)(l * 2 + 0) * 48 + n) * 2048 + k] = (bf16)hi; WR[((size_t)(l * 2 + 1) * 48 + n) * 2048 + k] = (bf16)(cvtpk(lo, 0.f) & 0xffffu); }
    }
}

__device__ __forceinline__ void s5_phase(const Args& a, LAS unsigned char* lds, int vcu, int G) {
    const int tid = threadIdx.x, lane = tid & 63, wave = __builtin_amdgcn_readfirstlane(tid >> 6), hi = lane >> 5, ql = lane & 31;
    unsigned char* ws = a.ws;
    const bf16* U0 = (const bf16*)(ws + WS_U0); bf16* G0 = (bf16*)(ws + WS_G0);
    const int pr = wave & 3; const bool producer = wave < 4;
    LAS unsigned char* pbase = lds + pr * 36864;
    LAS float* BU = (LAS float*)pbase;
    LAS unsigned* SSb = (LAS unsigned*)(pbase + 16384);
    volatile LAS unsigned* flg = (volatile LAS unsigned*)(pbase + 16384 + 17408);
    for (int item = vcu; item < 256; item += G) {
        const int b = item >> 5, g = 4 * (item & 31) + pr;
        const size_t base = (size_t)b * SEQ * D + (size_t)g * 16;
        __syncthreads();
        if (lane < 4 && producer) flg[lane] = 0u;
        __syncthreads();
        if (producer) {
            bf16x8 bm[4];
#pragma unroll
            for (int j = 0; j < 4; ++j) bm[j] = *(const bf16x8*)((const bf16*)(ws + WS_S5B) + (((size_t)g * 4 + j) * 64 + lane) * 8);
            const f32x2 lam = *(const f32x2*)((const float*)(ws + WS_LB) + ((size_t)g * 64 + lane) * 2);
            float sre = 0.f, sim = 0.f;
            bf16x8 ua = *(const bf16x8*)(U0 + base + (size_t)ql * D + 8 * hi), ub = *(const bf16x8*)(U0 + base + (size_t)(32 + ql) * D + 8 * hi);
            auto pbody = [&](const int blk, bf16x8& ur) {
                const int t0 = blk * 32, buf = blk & 1;
                const bf16x8 uf = ur;
#pragma unroll
                for (int j = 0; j < 4; ++j) {
                    f32x16 acc;
#pragma unroll
                    for (int i = 0; i < 16; ++i) acc[i] = 0.f;
                    acc = __builtin_amdgcn_mfma_f32_32x32x16_bf16(uf, bm[j], acc, 0, 0, 0);
#pragma unroll
                    for (int i = 0; i < 16; ++i) BU[((i & 3) + 8 * (i >> 2) + 4 * hi) * 128 + 32 * j + ql] = acc[i];
                }
                { const int tn = (blk < 62) ? t0 + 64 : t0; ur = *(const bf16x8*)(U0 + base + (size_t)(tn + ql) * D + 8 * hi); }
                LDS_WAIT();
                f32x2 bu[32];
#pragma unroll
                for (int t = 0; t < 32; ++t) bu[t] = *(const LAS f32x2*)(BU + t * 128 + 2 * lane);
                if (blk >= 2) { while (flg[2 + buf] < (unsigned)(blk - 1)) __builtin_amdgcn_s_sleep(1); }
                asm volatile("" ::: "memory");
                LAS unsigned* SS = SSb + buf * (32 * 68);
#pragma unroll
                for (int t = 0; t < 32; ++t) {
                    const float nre = lam.x * sre - lam.y * sim + bu[t].x, nim = lam.x * sim + lam.y * sre + bu[t].y;
                    sre = nre; sim = nim;
                    SS[t * 68 + lane] = cvtpk(sre, sim);
                }
                LDS_WAIT();
                if (lane == 0) flg[buf] = (unsigned)(blk + 1);
            };
#pragma clang loop unroll(disable)
            for (int blk = 0; blk < 64; blk += 2) { pbody(blk, ua); pbody(blk + 1, ub); }
        } else {
            bf16x8 cm[8], dm;
#pragma unroll
            for (int kk = 0; kk < 8; ++kk) cm[kk] = *(const bf16x8*)((const bf16*)(ws + WS_S5C) + (((size_t)g * 8 + kk) * 64 + lane) * 8);
            dm = *(const bf16x8*)((const bf16*)(ws + WS_S5D) + ((size_t)g * 64 + lane) * 8);
            bf16x8 ufn = *(const bf16x8*)(U0 + base + (size_t)ql * D + 8 * hi);
            bf16x8 bsel[2];
#pragma unroll
            for (int s2 = 0; s2 < 2; ++s2) { const int jj = ql - 16 * s2 - 8 * hi; u32x4 w;
                w.x = jj == 0 ? 0x3f80u : jj == 1 ? 0x3f800000u : 0u; w.y = jj == 2 ? 0x3f80u : jj == 3 ? 0x3f800000u : 0u;
                w.z = jj == 4 ? 0x3f80u : jj == 5 ? 0x3f800000u : 0u; w.w = jj == 6 ? 0x3f80u : jj == 7 ? 0x3f800000u : 0u; bsel[s2] = __builtin_bit_cast(bf16x8, w); }
            const int cri = (ql & 3) + 4 * (ql >> 3) + 32 * ((ql >> 2) & 1);
            __builtin_amdgcn_s_waitcnt(0x0F70);
            auto body = [&](const int blk, const bf16x8& uf, bf16x8& ufnx, const bool cv) {
                const int t0 = blk * 32, buf = blk & 1;
                { const int tn = (blk < 63) ? t0 + 32 : t0; ufnx = *(const bf16x8*)(U0 + base + (size_t)(tn + ql) * D + 8 * hi); }
                f32x4 cvv[2][2][2]; float cg[2] = {1.f, 1.f}; bf16* cdst = nullptr; int cK = 0;
                if (cv) {
                    const int q = (3 * (blk >> 2) + (blk & 3)) * 1024 + item * 4 + pr;
                    const int e = q / 1536, r = q - e * 1536, kind = r >> 9, sub = r & 511;
                    const float* src; int ldn; const float* gp = a.in[19];
                    if (kind < 2) { const int kp = sub >> 4, n0 = 32 * (sub & 15);
                        src = a.in[24 + kind] + (size_t)e * 2048 * 512 + (size_t)(64 * kp) * 512 + n0; ldn = 512; cK = 2048;
                        cdst = (bf16*)(ws + WS_WGU) + (size_t)e * 1024 * 2048 + (size_t)(256 * (n0 >> 7) + 128 * kind + (n0 & 127)) * 2048 + 64 * kp;
                        gp += 64 * kp;
                    } else { const int kp = sub >> 6, n0 = 32 * (sub & 63);
                        src = a.in[26] + (size_t)e * 512 * 2048 + (size_t)(64 * kp) * 2048 + n0; ldn = 2048; cK = 512;
                        cdst = (bf16*)(ws + WS_WDN) + (size_t)e * 2048 * 512 + (size_t)n0 * 512 + 64 * kp; }
                    { const float g0 = gp[cri], g1 = gp[cri + 16]; cg[0] = kind < 2 ? g0 : 1.f; cg[1] = kind < 2 ? g1 : 1.f; }
#pragma unroll
                    for (int t = 0; t < 2; ++t)
#pragma unroll
                        for (int s2 = 0; s2 < 2; ++s2) { const float* p = src + (size_t)(cri + 16 * t) * ldn + 16 * s2 + 8 * hi;
                            cvv[t][s2][0] = *(const f32x4*)p; cvv[t][s2][1] = *(const f32x4*)(p + 4); }
                }
                while (flg[buf] < (unsigned)(blk + 1)) __builtin_amdgcn_s_sleep(1);
                asm volatile("" ::: "memory");
                const LAS unsigned* SS = SSb + buf * (32 * 68);
                bf16x8 sf[8];
#pragma unroll
                for (int kk = 0; kk < 8; ++kk) sf[kk] = *(const LAS bf16x8*)(SS + ql * 68 + 8 * kk + 4 * hi);
                LDS_WAIT();
                if (lane == 0) flg[2 + buf] = (unsigned)(blk + 1);
                f32x16 y;
#pragma unroll
                for (int i = 0; i < 16; ++i) y[i] = 0.f;
#pragma unroll
                for (int kk = 0; kk < 8; ++kk) y = __builtin_amdgcn_mfma_f32_32x32x16_bf16(sf[kk], cm[kk], y, 0, 0, 0);
                y = __builtin_amdgcn_mfma_f32_32x32x16_bf16(uf, dm, y, 0, 0, 0);
                LAS unsigned short* YT = (LAS unsigned short*)(pbase + 16384 + 17408 + 64 + (blk & 1) * 1024);
                if (ql < 16) {
#pragma unroll
                    for (int i = 0; i < 16; ++i) { const int tl = (i & 3) + 8 * (i >> 2) + 4 * hi; YT[tl * 16 + ql] = (unsigned short)(cvtpk(gelu_tanh(y[i]), 0.f) & 0xffffu); }
                }
                LDS_WAIT();
                { const u32x4 w0 = *(const LAS u32x4*)(YT + lane * 8);
                    bf16* o = G0 + base + (size_t)(t0 + (lane >> 1)) * D + 8 * (lane & 1); *(u32x4*)o = w0; }
                LDS_WAIT();
                if (cv) {
#pragma unroll
                    for (int t = 0; t < 2; ++t) { f32x16 ca;
#pragma unroll
                        for (int i = 0; i < 16; ++i) ca[i] = 0.f;
#pragma unroll
                        for (int s2 = 0; s2 < 2; ++s2) ca = __builtin_amdgcn_mfma_f32_32x32x16_bf16(__builtin_bit_cast(bf16x8, pack8(cvv[t][s2][0] * cg[t], cvv[t][s2][1] * cg[t])), bsel[s2], ca, 0, 0, 0);
                        bf16* o = cdst + (size_t)ql * cK + 32 * hi + 16 * t;
                        *(u32x4*)o = pack8((f32x4){ca[0], ca[1], ca[2], ca[3]}, (f32x4){ca[4], ca[5], ca[6], ca[7]});
                        *(u32x4*)(o + 8) = pack8((f32x4){ca[8], ca[9], ca[10], ca[11]}, (f32x4){ca[12], ca[13], ca[14], ca[15]}); }
                }
            };
            bf16x8 ufa = ufn, ufb = ufn;
#pragma clang loop unroll(disable)
            for (int blk = 0; blk < 64; blk += 4) { body(blk, ufa, ufb, true); body(blk + 1, ufb, ufa, true); body(blk + 2, ufa, ufb, true); body(blk + 3, ufb, ufa, false); }
        }
    }
}

__device__ __forceinline__ void router_phase(const Args& a, int layer, const bf16* H, LAS unsigned char* lds, int vcu, int G) {
    const int tid = threadIdx.x, lane = tid & 63, wave = __builtin_amdgcn_readfirstlane(tid >> 6), fr = lane & 15, fq = lane >> 4;
    unsigned char* ws = a.ws;
    const bf16* WR = (const bf16*)(ws + WS_WR) + (size_t)layer * 2 * 48 * 2048;
    LAS float* red = (LAS float*)lds;
    LAS float* fin = (LAS float*)(lds + 106496);
    const float* gb = a.in[21] + layer * 4; const float* eb = a.in[23] + layer * 32;
    for (int item = vcu; item < T / 64; item += G) {
        const int t0 = item * 64;
        f32x4 acc[4][3];
#pragma unroll
        for (int mt = 0; mt < 4; ++mt)
#pragma unroll
            for (int i = 0; i < 3; ++i) acc[mt][i] = (f32x4){0.f, 0.f, 0.f, 0.f};
        float ss[4] = {0.f, 0.f, 0.f, 0.f};
        const bf16* hp = H + (size_t)(t0 + fr) * D + wave * 256 + 8 * fq;
        const bf16* wp = WR + (size_t)fr * 2048 + wave * 256 + 8 * fq;
#pragma unroll 2
        for (int ks = 0; ks < 8; ++ks) {
            bf16x8 af[4], wh[3], wl[3];
#pragma unroll
            for (int mt = 0; mt < 4; ++mt) af[mt] = *(const bf16x8*)(hp + (size_t)mt * 16 * D + ks * 32);
#pragma unroll
            for (int nt = 0; nt < 3; ++nt) { wh[nt] = *(const bf16x8*)(wp + (size_t)nt * 16 * 2048 + ks * 32); wl[nt] = *(const bf16x8*)(wp + (size_t)(48 + nt * 16) * 2048 + ks * 32); }
#pragma unroll
            for (int mt = 0; mt < 4; ++mt) {
                const u32x4 au = __builtin_bit_cast(u32x4, af[mt]);
#pragma unroll
                for (int i = 0; i < 4; ++i) { const float lo = bflo(au[i]), hi2 = bfhi(au[i]); ss[mt] += lo * lo + hi2 * hi2; }
#pragma unroll
                for (int nt = 0; nt < 3; ++nt) {
                    acc[mt][nt] = __builtin_amdgcn_mfma_f32_16x16x32_bf16(wh[nt], af[mt], acc[mt][nt], 0, 0, 0);
                    acc[mt][nt] = __builtin_amdgcn_mfma_f32_16x16x32_bf16(wl[nt], af[mt], acc[mt][nt], 0, 0, 0);
                }
            }
        }
#pragma unroll
        for (int mt = 0; mt < 4; ++mt) {
#pragma unroll
            for (int nt = 0; nt < 3; ++nt) *(LAS f32x4*)(red + (wave * 64 + 16 * mt + fr) * 52 + 16 * nt + 4 * fq) = acc[mt][nt];
            float s1 = ss[mt]; s1 += __shfl_xor(s1, 16); s1 += __shfl_xor(s1, 32);
            if (fq == 0) red[(wave * 64 + 16 * mt + fr) * 52 + 48] = s1;
        }
        __syncthreads();
        for (int i = tid; i < 64 * 49; i += NTHR) { const int tk = i / 49, e = i - tk * 49; float sum = 0.f;
#pragma unroll
            for (int w = 0; w < 8; ++w) sum += red[(w * 64 + tk) * 52 + e];
            fin[tk * 52 + e] = sum; }
        __syncthreads();
        if (tid < 64) {
            const LAS float* f = fin + tid * 52; const int tok = t0 + tid;
            const float sr = rsqrtf(f[48] * (1.f / D) + EPS);
            float gl[4];
#pragma unroll
            for (int j = 0; j < 4; ++j) gl[j] = sr * f[j] + gb[j];
            int gi = 0; float gm = gl[0];
#pragma unroll
            for (int j = 1; j < 4; ++j) if (gl[j] > gm) { gm = gl[j]; gi = j; }
            float gs = 0.f;
#pragma unroll
            for (int j = 0; j < 4; ++j) gs += __expf(gl[j] - gm);
            const float gprob = 1.f / gs;
            int i0 = 0, i1 = 0; float v0 = -3.0e38f, v1 = -3.0e38f;
            for (int j = 0; j < 8; ++j) { const float v = sr * f[4 + 8 * gi + j] + eb[8 * gi + j];
                if (v > v0) { v1 = v0; i1 = i0; v0 = v; i0 = j; } else if (v > v1) { v1 = v; i1 = j; } }
            const float ex = __expf(v1 - v0); const float w0 = gprob / (1.f + ex), w1 = gprob * ex / (1.f + ex);
            const int e0 = 8 * gi + i0, e1 = 8 * gi + i1;
            u32x4 rec; rec.x = (unsigned)(e0 | (e1 << 8)); rec.y = __float_as_uint(w0); rec.z = __float_as_uint(w1); rec.w = __float_as_uint(sr);
            *((u32x4*)(ws + WS_TOKREC) + tok) = rec;
        }
        __syncthreads();
    }
}

__device__ __forceinline__ void build_lists(unsigned char* ws, unsigned* cnt, LAS unsigned char* lds, int vcu, int G) {
    const int tid = threadIdx.x, lane = tid & 63, wave = __builtin_amdgcn_readfirstlane(tid >> 6);
    const u32x4* rec = (const u32x4*)(ws + WS_TOKREC);
    int* rinfo = (int*)(ws + WS_RINFO); float* rw = (float*)(ws + WS_RW); float* rr = (float*)(ws + WS_RR);
    LAS int* sc = (LAS int*)lds;
    for (int e = vcu; e < 32; e += G) {
        unsigned m0 = 0u, m1 = 0u;
        for (int j = 0; j < 32; ++j) { const unsigned dec = rec[32 * tid + j].x; m0 |= ((dec & 255u) == (unsigned)e ? 1u : 0u) << j; m1 |= (((dec >> 8) & 255u) == (unsigned)e ? 1u : 0u) << j; }
        const int c = __popc(m0 | m1);
        int incl = c;
#pragma unroll
        for (int o = 1; o < 64; o <<= 1) { const int v = __shfl_up(incl, o); if (lane >= o) incl += v; }
        __syncthreads();
        if (lane == 63) sc[wave] = incl;
        __syncthreads();
        int wbase = 0, total = 0;
        for (int w = 0; w < 8; ++w) { const int v = sc[w]; total += v; if (w < wave) wbase += v; }
        size_t pos = (size_t)e * T + (size_t)(wbase + incl - c);
        unsigned mm = m0 | m1;
        while (mm) { const int j = __ffs(mm) - 1; mm &= mm - 1u; const int t = 32 * tid + j; const unsigned sl = (m1 >> j) & 1u; const u32x4 r = rec[t];
            rinfo[pos] = (t << 1) | (int)sl; rw[pos] = __uint_as_float(sl ? r.z : r.y); rr[pos] = __uint_as_float(r.w); ++pos; }
        if (tid == 0) cnt[e * 32] = (unsigned)total;
    }
}
__device__ __forceinline__ void moe_prefix(unsigned* cnt, LAS int* pre) {
    __syncthreads();
    if (threadIdx.x < 32) pre[40 + threadIdx.x] = (int)__hip_atomic_load(cnt + threadIdx.x * 32, __ATOMIC_RELAXED, __HIP_MEMORY_SCOPE_AGENT);
    __syncthreads();
    if (threadIdx.x == 0) { int s = 0; for (int e = 0; e < 32; ++e) { pre[e] = s; s += (pre[40 + e] + 255) >> 8; } pre[32] = s; }
    __syncthreads();
}

__device__ __forceinline__ void combine_phase(const bf16* hin, const bf16* slot, bf16* hout, float* rs, int vcu, int G) {
    const int tid = threadIdx.x, lane = tid & 63, wave = __builtin_amdgcn_readfirstlane(tid >> 6);
    const int gw = vcu * NWAVES + wave, NGW = G * NWAVES;
    for (int row = gw; row < T; row += NGW) {
        float ss = 0.f;
#pragma unroll
        for (int j = 0; j < 4; ++j) { const size_t off = (size_t)row * D + j * 512 + lane * 8;
            const u32x4 h = *(const u32x4*)(hin + off), s0 = *(const u32x4*)(slot + off), s1 = *(const u32x4*)(slot + (size_t)T * D + off); u32x4 w;
#pragma unroll
            for (int i = 0; i < 4; ++i) { const float lo = bflo(h[i]) + bflo(s0[i]) + bflo(s1[i]), hi2 = bfhi(h[i]) + bfhi(s0[i]) + bfhi(s1[i]); ss += lo * lo + hi2 * hi2; w[i] = cvtpk(lo, hi2); }
            *(u32x4*)(hout + off) = w; }
        ss = wave_sum(ss);
        if (lane == 0) rs[row] = rsqrtf(ss * (1.f / D) + EPS);
    }
}
__device__ __forceinline__ void final_phase(const bf16* hin, const float* g, float* out, int vcu, int G) {
    const int tid = threadIdx.x, lane = tid & 63, wave = __builtin_amdgcn_readfirstlane(tid >> 6);
    const int gw = vcu * NWAVES + wave, NGW = G * NWAVES;
    for (int row = gw; row < T; row += NGW) {
        float ss = 0.f; u32x4 h[4];
#pragma unroll
        for (int j = 0; j < 4; ++j) { h[j] = *(const u32x4*)(hin + (size_t)row * D + j * 512 + lane * 8);
#pragma unroll
            for (int i = 0; i < 4; ++i) { const float lo = bflo(h[j][i]), hi2 = bfhi(h[j][i]); ss += lo * lo + hi2 * hi2; } }
        const float r = rsqrtf(wave_sum(ss) * (1.f / D) + EPS);
#pragma unroll
        for (int j = 0; j < 4; ++j) { const f32x4 g0 = *(const f32x4*)(g + j * 512 + lane * 8), g1 = *(const f32x4*)(g + j * 512 + lane * 8 + 4); f32x4 o0, o1;
            o0[0] = bflo(h[j][0]) * r * g0[0]; o0[1] = bfhi(h[j][0]) * r * g0[1]; o0[2] = bflo(h[j][1]) * r * g0[2]; o0[3] = bfhi(h[j][1]) * r * g0[3];
            o1[0] = bflo(h[j][2]) * r * g1[0]; o1[1] = bfhi(h[j][2]) * r * g1[1]; o1[2] = bflo(h[j][3]) * r * g1[2]; o1[3] = bfhi(h[j][3]) * r * g1[3];
            __builtin_nontemporal_store(o0, (f32x4*)(out + (size_t)row * D + j * 512 + lane * 8)); __builtin_nontemporal_store(o1, (f32x4*)(out + (size_t)row * D + j * 512 + lane * 8 + 4)); }
    }
}

__device__ __forceinline__ int kvoff(int row, int ch) { return 256 * row + 16 * (ch ^ (((row & 3) << 2) | ((row >> 2) & 3))); }
__device__ __forceinline__ void attn_unit_params(int ui, int& pat, int& b, int& kvh, int& dsh, int& r, int& n) {
    const int x = ui & 15; kvh = (ui >> 4) & 7; b = (ui >> 7) & 7; pat = ui >> 10;
    dsh = 2 * pat; const int nsh = 4 - dsh;
    r = x >> nsh; n = x & ((1 << nsh) - 1);
}
__device__ __forceinline__ void attn_kv_load(const bf16* Kb, const bf16* Vb, int ui, int tid, u32x4 (&kr)[8], u32x4 (&vr)[8]) {
    int pat, b, kvh, dsh, r, n; attn_unit_params(ui, pat, b, kvh, dsh, r, n);
    const size_t rowbase = (size_t)b * SEQ;
#pragma unroll
    for (int pass = 0; pass < 8; ++pass) {
        const int row = pass * 32 + (tid >> 4), ch = tid & 15, spos = 128 * (n - 1) + row;
        if (spos >= 0) { const size_t tok = rowbase + ((size_t)spos << dsh) + r;
            kr[pass] = *(const u32x4*)(Kb + tok * 1024 + kvh * 128 + ch * 8); vr[pass] = *(const u32x4*)(Vb + tok * 1024 + kvh * 128 + ch * 8); }
    }
}
__device__ __forceinline__ void attn_phase(const Args& a, LAS unsigned char* lds, int vcu, int G) {
    const int tid = threadIdx.x, lane = tid & 63, wave = __builtin_amdgcn_readfirstlane(tid >> 6), hi = lane >> 5, ql = lane & 31;
    unsigned char* ws = a.ws;
    const bf16* Kb = (const bf16*)(ws + WS_KB); const bf16* Vb = (const bf16*)(ws + WS_VB); bf16* Q = (bf16*)(ws + WS_Q); float* lse = (float*)(ws + WS_LSE);
    LAS unsigned char* Ks = lds; LAS unsigned char* Vs = lds + 65536;
    const int i0w = 32 * (wave & 3);
    const int g4 = lane >> 4, li = lane & 15, tq = li >> 2, tp = li & 3;
    int kA[8], vA[2][4];
#pragma unroll
    for (int kk = 0; kk < 8; ++kk) kA[kk] = kvoff(i0w + ql, 2 * kk + hi);
#pragma unroll
    for (int h2 = 0; h2 < 2; ++h2)
#pragma unroll
        for (int dt = 0; dt < 4; ++dt) vA[h2][dt] = 65536 + kvoff(i0w + 4 * hi + tq + 8 * h2, 4 * dt + 2 * (g4 & 1) + (tp >> 1)) + 8 * (tp & 1);
    u32x4 kr[8], vr[8];
    if (vcu < 3072) attn_kv_load(Kb, Vb, vcu, tid, kr, vr);
    for (int ui = vcu; ui < 3072; ui += G) {
        int pat, b, kvh, dsh, r, n; attn_unit_params(ui, pat, b, kvh, dsh, r, n);
        const size_t rowbase = (size_t)b * SEQ;
        const int head = 2 * kvh + (wave >> 2), i0 = 32 * (wave & 3);
        const int sq = 128 * n + i0 + ql; const size_t tokq = rowbase + ((size_t)sq << dsh) + r;
        bf16* qrow = Q + tokq * 6144 + (size_t)(pat * 16 + head) * 128;
        bf16x8 qf[8];
#pragma unroll
        for (int kk = 0; kk < 8; ++kk) qf[kk] = *(const bf16x8*)(qrow + 16 * kk + 8 * hi);
#pragma unroll
        for (int pass = 0; pass < 8; ++pass) {
            const int row = pass * 32 + (tid >> 4), ch = tid & 15, spos = 128 * (n - 1) + row;
            if (spos >= 0) { *(LAS u32x4*)(Ks + kvoff(row, ch)) = kr[pass]; *(LAS u32x4*)(Vs + kvoff(row, ch)) = vr[pass]; }
        }
        __syncthreads();
        f32x16 S[5];
#pragma unroll
        for (int j = 0; j < 5; ++j) {
            const int kr0 = i0 + 32 * j; const bool valid = (n > 0) || (kr0 >= 128);
            f32x16 sacc;
#pragma unroll
            for (int i = 0; i < 16; ++i) sacc[i] = 0.f;
            if (valid) {
#pragma unroll
                for (int kk = 0; kk < 8; ++kk) { const bf16x8 kf = *(const LAS bf16x8*)(lds + kA[kk] + 8192 * j); sacc = __builtin_amdgcn_mfma_f32_32x32x16_bf16(kf, qf[kk], sacc, 0, 0, 0); }
            }
#pragma unroll
            for (int i = 0; i < 16; ++i) { const int c = (i & 3) + 8 * (i >> 2) + 4 * hi; bool ok = valid; if (j == 0) ok = ok && (c >= ql); if (j == 4) ok = ok && (c <= ql); sacc[i] = ok ? sacc[i] : -1e30f; }
            S[j] = sacc;
        }
        float mx = -1e30f;
#pragma unroll
        for (int j = 0; j < 5; ++j)
#pragma unroll
            for (int i = 0; i < 16; ++i) mx = fmaxf(mx, S[j][i]);
        mx = fmaxf(mx, __shfl_xor(mx, 32));
        float den = 0.f;
#pragma unroll
        for (int j = 0; j < 5; ++j)
#pragma unroll
            for (int i = 0; i < 16; ++i) { const float e = __builtin_amdgcn_exp2f((S[j][i] - mx) * 1.4426950408889634f); S[j][i] = e; den += e; }
        den += __shfl_xor(den, 32);
        bf16x8 pfr[5][2];
#pragma unroll
        for (int j = 0; j < 5; ++j)
#pragma unroll
            for (int s2 = 0; s2 < 2; ++s2) { u32x4 pw; pw.x = cvtpk(S[j][8 * s2 + 0], S[j][8 * s2 + 1]); pw.y = cvtpk(S[j][8 * s2 + 2], S[j][8 * s2 + 3]); pw.z = cvtpk(S[j][8 * s2 + 4], S[j][8 * s2 + 5]); pw.w = cvtpk(S[j][8 * s2 + 6], S[j][8 * s2 + 7]);
                pfr[j][s2] = __builtin_bit_cast(bf16x8, pw); }
        if (ui + G < 3072) attn_kv_load(Kb, Vb, ui + G, tid, kr, vr);
        f32x16 O[4];
#pragma unroll
        for (int dt = 0; dt < 4; ++dt)
#pragma unroll
            for (int i = 0; i < 16; ++i) O[dt][i] = 0.f;
#pragma unroll
        for (int j = 0; j < 5; ++j) {
            const int kr0 = i0 + 32 * j; const bool valid = (n > 0) || (kr0 >= 128);
            if (valid) {
#pragma unroll
                for (int s2 = 0; s2 < 2; ++s2) {
                    const bf16x8 pf = pfr[j][s2];
#pragma unroll
                    for (int dt = 0; dt < 4; ++dt) {
                        const s16x4 v0 = __builtin_amdgcn_ds_read_tr16_b64_v4i16((LAS s16x4*)(lds + vA[0][dt] + 8192 * j + 4096 * s2));
                        const s16x4 v1 = __builtin_amdgcn_ds_read_tr16_b64_v4i16((LAS s16x4*)(lds + vA[1][dt] + 8192 * j + 4096 * s2));
                        bf16x8 vf; vf[0] = v0[0]; vf[1] = v0[1]; vf[2] = v0[2]; vf[3] = v0[3]; vf[4] = v1[0]; vf[5] = v1[1]; vf[6] = v1[2]; vf[7] = v1[3];
                        O[dt] = __builtin_amdgcn_mfma_f32_32x32x16_bf16(vf, pf, O[dt], 0, 0, 0);
                    }
                }
            }
        }
        const float inv = __builtin_amdgcn_rcpf(den);
#pragma unroll
        for (int dt = 0; dt < 4; ++dt)
#pragma unroll
            for (int qp = 0; qp < 2; ++qp) {
                u32x2 we, wo;
                we.x = cvtpk(O[dt][8 * qp] * inv, O[dt][8 * qp + 1] * inv); we.y = cvtpk(O[dt][8 * qp + 2] * inv, O[dt][8 * qp + 3] * inv);
                wo.x = cvtpk(O[dt][8 * qp + 4] * inv, O[dt][8 * qp + 5] * inv); wo.y = cvtpk(O[dt][8 * qp + 6] * inv, O[dt][8 * qp + 7] * inv);
                const u32x2 give = hi ? we : wo;
                u32x2 got; got.x = (unsigned)__shfl_xor((int)give.x, 32); got.y = (unsigned)__shfl_xor((int)give.y, 32);
                u32x4 w16; if (hi) { w16.x = got.x; w16.y = got.y; w16.z = wo.x; w16.w = wo.y; } else { w16.x = we.x; w16.y = we.y; w16.z = got.x; w16.w = got.y; }
                *(u32x4*)(qrow + 32 * dt + 16 * qp + 8 * hi) = w16; }
        if (hi == 0) lse[((size_t)pat * T + tokq) * 16 + head] = mx + __logf(den);
        __syncthreads();
    }
}
__device__ __forceinline__ void merge_phase(const Args& a, int vcu, int G) {
    const int tid = threadIdx.x, lane = tid & 63, wave = __builtin_amdgcn_readfirstlane(tid >> 6);
    const int gw = vcu * NWAVES + wave, NGW = G * NWAVES;
    unsigned char* ws = a.ws; const bf16* Q = (const bf16*)(ws + WS_Q); const float* lse = (const float*)(ws + WS_LSE); bf16* O = (bf16*)(ws + WS_O);
    for (int row = gw; row < T; row += NGW) {
#pragma unroll
        for (int j = 0; j < 4; ++j) { const int head = 4 * j + (lane >> 4), d0 = (lane & 15) * 8;
            const float l0 = lse[((size_t)0 * T + row) * 16 + head], l1 = lse[((size_t)1 * T + row) * 16 + head], l2 = lse[((size_t)2 * T + row) * 16 + head];
            const float mx = fmaxf(l0, fmaxf(l1, l2)); float w0 = __expf(l0 - mx), w1 = __expf(l1 - mx), w2 = __expf(l2 - mx); const float inv = 1.f / (w0 + w1 + w2); w0 *= inv; w1 *= inv; w2 *= inv;
            const u32x4 o0 = *(const u32x4*)(Q + (size_t)row * 6144 + (0 * 16 + head) * 128 + d0), o1 = *(const u32x4*)(Q + (size_t)row * 6144 + (1 * 16 + head) * 128 + d0), o2 = *(const u32x4*)(Q + (size_t)row * 6144 + (2 * 16 + head) * 128 + d0);
            u32x4 w;
#pragma unroll
            for (int i = 0; i < 4; ++i) w[i] = cvtpk(w0 * bflo(o0[i]) + w1 * bflo(o1[i]) + w2 * bflo(o2[i]), w0 * bfhi(o0[i]) + w1 * bfhi(o1[i]) + w2 * bfhi(o2[i]));
            *(u32x4*)(O + (size_t)row * D + head * 128 + d0) = w; }
    }
}

#define GEMM_RUN(K, S, E) pg8::gemm_phase<false, true>(lds, K, S, E)
#define GEMM_RUN_G(K, S, E) pg8::gemm_phase<true, true>(lds, K, S, E)
#define GEMM_RUN_2ND(K, S, E) pg8::gemm_phase<false, true, true>(lds, K, S, E)
__global__ void __launch_bounds__(NTHR, 2) fwd(Args a) {
    extern __shared__ __attribute__((aligned(16))) unsigned char lds_raw[];
    LAS unsigned char* lds = (LAS unsigned char*)lds_raw;
    const int tid = threadIdx.x;
    const int G = gridDim.x; const int bx = blockIdx.x; const int vcu = (G % 8 == 0) ? (bx % 8) * (G / 8) + bx / 8 : bx;
    unsigned char* ws = a.ws;
    unsigned* ctl = (unsigned*)(ws + WS_CTL);
    volatile LAS unsigned* MISC = (volatile LAS unsigned*)(lds + 146 * 1024);
    LAS int* pre = (LAS int*)(lds + 147 * 1024);
    if (tid < 64) MISC[tid] = 0u;
    __syncthreads();
    const int lo = a.ph_lo, hi = a.ph_hi;
    XcdBarrier bar; bar.bar = ctl + CW_BAR; bar.x = 0; bar.st = nullptr;
    if (hi - lo > 1) bar = xcd_barrier_post(ctl + CW_BAR, MISC + 8);
#ifndef PHM
#define PHM 0xfffff
#endif
#define IN(k) (((PHM >> (k)) & 1) && lo <= (k) && (k) < hi)
#define SEAM(k) do { if (IN(k) && IN((k) + 1)) xcd_barrier(bar); } while (0)
#define HA ((bf16*)(a.ws + WS_HA))
#define HB ((bf16*)(a.ws + WS_HB))
#define RS ((float*)(a.ws + WS_RSTAT))
#define rinfo ((const int*)(a.ws + WS_RINFO))

    if (IN(0)) { p0_prologue(a, lds, vcu, G); } SEAM(0);
    if (IN(1)) {
        s5_phase(a, lds, vcu, G);
    } SEAM(1);
    if (IN(2)) {
        DenseSched S{(const bf16*)(ws + WS_G0), (const bf16*)(ws + WS_WGLU), 2048, 64, 16, G, bx};
        EpiGLU E{a.in[0], a.in[12], HA};
        GEMM_RUN(2048, S, E);
    } SEAM(2);
    if (IN(3)) { router_phase(a, 0, HA, lds, vcu, G); } SEAM(3);
    if (IN(4)) { build_lists(ws, ctl + CW_CNT, lds, vcu, G); } SEAM(4);
    if (IN(5)) {
        moe_prefix(ctl + CW_CNT, pre);
        MoeSched S{HA, (const bf16*)(ws + WS_WGU), rinfo, pre, 2048, 4, G, bx, (size_t)1024 * 2048, true};
        EpiGateUp E{(const float*)(ws + WS_RR), (const float*)(ws + WS_RW), (bf16*)(ws + WS_HID), rinfo};
        GEMM_RUN_G(2048, S, E);
        {
            const int tot = pre[32] * 4; const int R = (tot % G == 0) ? 0 : tot % G;
            FillSched SF{(const bf16*)(ws + WS_PBF), (const bf16*)(ws + WS_WPP), 256, 64, 8, G, bx, R};
            EpiStore EF{(bf16*)(ws + WS_PP), D};
            GEMM_RUN_2ND(256, SF, EF); }
    } SEAM(5);
    if (IN(6)) {
        moe_prefix(ctl + CW_CNT, pre);
        MoeSched S{(const bf16*)(ws + WS_HID), (const bf16*)(ws + WS_WDN), rinfo, pre, 512, 8, G, bx, (size_t)2048 * 512, false};
        EpiDown E{(bf16*)(ws + WS_SLOT)};
        GEMM_RUN(512, S, E);
    } SEAM(6);
    if (IN(7)) { combine_phase(HA, (const bf16*)(ws + WS_SLOT), HB, RS, vcu, G); } SEAM(7);
    if (IN(8)) {
        DenseSched S{HB, (const bf16*)(ws + WS_WPG), 2048, 64, 8, G, bx};
        EpiPLE E{HB, (const bf16*)(ws + WS_PP), RS, HA, (float*)(ws + WS_PART)};
        GEMM_RUN(2048, S, E);
    } SEAM(8);
    if (IN(9)) {
        DenseSched S{HA, (const bf16*)(ws + WS_WQKV), 2048, 64, 32, G, bx};
        EpiQKV E{(const float*)(ws + WS_PART), (const float*)(ws + WS_ROPE), (bf16*)(ws + WS_Q), (bf16*)(ws + WS_KB), (bf16*)(ws + WS_VB)};
        GEMM_RUN(2048, S, E);
    } SEAM(9);
    if (IN(10)) { attn_phase(a, lds, vcu, G); } SEAM(10);
    if (IN(11)) { merge_phase(a, vcu, G); } SEAM(11);
    if (IN(12)) {
        DenseSched S{(const bf16*)(ws + WS_O), (const bf16*)(ws + WS_WO), 2048, 64, 8, G, bx};
        EpiResAdd E{HA, HB};
        GEMM_RUN(2048, S, E);
    } SEAM(12);
    if (IN(13)) {
        router_phase(a, 1, HB, lds, vcu, G);
        const int lane = tid & 63, wave = __builtin_amdgcn_readfirstlane(tid >> 6);
        moe_weights(a, 1, vcu * NWAVES + wave, G * NWAVES, lds + wave * 16384, lane);
    } SEAM(13);
    if (IN(14)) { build_lists(ws, ctl + CW_CNT + 1024, lds, vcu, G); } SEAM(14);
    if (IN(15)) {
        moe_prefix(ctl + CW_CNT + 1024, pre);
        MoeSched S{HB, (const bf16*)(ws + WS_WGU), rinfo, pre, 2048, 4, G, bx, (size_t)1024 * 2048, true};
        EpiGateUp E{(const float*)(ws + WS_RR), (const float*)(ws + WS_RW), (bf16*)(ws + WS_HID), rinfo};
        GEMM_RUN_G(2048, S, E);
        {
            const int tot = pre[32] * 4; const int R = (tot % G == 0) ? 0 : tot % G;
            FillSched SF{(const bf16*)(ws + WS_PBF) + (size_t)T * 256, (const bf16*)(ws + WS_WPP) + (size_t)2048 * 256, 256, 64, 8, G, bx, R};
            EpiStore EF{(bf16*)(ws + WS_PP) + (size_t)T * D, D};
            GEMM_RUN_2ND(256, SF, EF); }
    } SEAM(15);
    if (IN(16)) {
        moe_prefix(ctl + CW_CNT + 1024, pre);
        MoeSched S{(const bf16*)(ws + WS_HID), (const bf16*)(ws + WS_WDN), rinfo, pre, 512, 8, G, bx, (size_t)2048 * 512, false};
        EpiDown E{(bf16*)(ws + WS_SLOT)};
        GEMM_RUN(512, S, E);
    } SEAM(16);
    if (IN(17)) { combine_phase(HB, (const bf16*)(ws + WS_SLOT), HA, RS, vcu, G); } SEAM(17);
    if (IN(18)) {
        DenseSched S{HA, (const bf16*)(ws + WS_WPG) + (size_t)2048 * 2048, 2048, 64, 8, G, bx};
        EpiPLE E{HA, (const bf16*)(ws + WS_PP) + (size_t)T * D, RS, HB, (float*)(ws + WS_PART)};
        GEMM_RUN(2048, S, E);
    } SEAM(18);
    if (IN(19)) { final_phase(HB, a.in[30], a.out, vcu, G); }
#undef IN
#undef SEAM
#undef HA
#undef HB
#undef RS
#undef rinfo
}

extern "C" void kernel_launch(void* const* d_in, const int* in_sizes, int n_in, void* d_out, int out_size, void* d_ws, size_t ws_size, hipStream_t stream) {
    static int grid = 0;
    if (grid == 0) {
        if (n_in != 31 || out_size != T * D || ws_size < WS_END) { fprintf(stderr, "kernel_launch: unexpected shapes (n_in %d, out %d, ws %zu)\n", n_in, out_size, ws_size); grid = -1; return; }
        int dev = 0, cus = 0, per_cu = 0;
        if (hipGetDevice(&dev) != hipSuccess || hipDeviceGetAttribute(&cus, hipDeviceAttributeMultiprocessorCount, dev) != hipSuccess) { grid = -1; return; }
        if (hipFuncSetAttribute((const void*)fwd, hipFuncAttributeMaxDynamicSharedMemorySize, LDS_BYTES) != hipSuccess) { fprintf(stderr, "kernel_launch: hipFuncSetAttribute failed\n"); grid = -1; return; }
        if (hipOccupancyMaxActiveBlocksPerMultiprocessor(&per_cu, (const void*)fwd, NTHR, LDS_BYTES) != hipSuccess || per_cu < 1) fprintf(stderr, "kernel_launch: occupancy query reports %d\n", per_cu);
        (void)hipGetLastError();
        grid = cus;
    }
    if (grid < 0) return;
    if (hipMemsetAsync((char*)d_ws + WS_CTL, 0, CTL_ZERO_BYTES, stream) != hipSuccess) return;
    Args a{};
    for (int i = 0; i < 31; ++i) a.in[i] = (const float*)d_in[i];
    a.out = (float*)d_out; a.ws = (unsigned char*)d_ws;
#if MK_N_LAUNCHES == 1
    a.ph_lo = 0; a.ph_hi = NPH;
    hipLaunchKernelGGL(fwd, dim3(grid), dim3(NTHR), LDS_BYTES, stream, a);
#else
    for (int p = 0; p < NPH; ++p) { a.ph_lo = p; a.ph_hi = p + 1; hipLaunchKernelGGL(fwd, dim3(grid), dim3(NTHR), LDS_BYTES, stream, a); }
#endif
}
```

```cpp
#include <hip/hip_runtime.h>
#include <cstdio>
#include <cstdint>

#define GAS __attribute__((address_space(1)))
#define LAS __attribute__((address_space(3)))
typedef unsigned short bf16;
typedef short bf16x8 __attribute__((ext_vector_type(8)));
typedef short s16x4 __attribute__((ext_vector_type(4)));
typedef float f32x2 __attribute__((ext_vector_type(2)));
typedef float f32x4 __attribute__((ext_vector_type(4)));
typedef float f32x16 __attribute__((ext_vector_type(16)));
typedef unsigned u32x2 __attribute__((ext_vector_type(2)));
typedef unsigned u32x4 __attribute__((ext_vector_type(4)));
typedef __bf16 bf16x2_t __attribute__((ext_vector_type(2)));

#ifndef MK_N_LAUNCHES
#define MK_N_LAUNCHES 1
#endif

constexpr int T = 16384, D = 2048, SEQ = 2048;
constexpr int NWAVES = 8, NTHR = 512;
constexpr int NPH = 20;
constexpr float EPS = 1e-6f;
constexpr int LDS_BYTES = 159744;

constexpr size_t MiB = 1u << 20;
constexpr size_t WS_CTL = 0, CTL_ZERO_BYTES = 1 * MiB;
constexpr size_t WS_ROPE = 1 * MiB;
constexpr size_t WS_S5B = 2 * MiB;
constexpr size_t WS_S5D = 2 * MiB + 512 * 1024;
constexpr size_t WS_LB = 2 * MiB + 768 * 1024;
constexpr size_t WS_S5C = 3 * MiB;
constexpr size_t WS_WR = 4 * MiB;
constexpr size_t WS_RSTAT = 5 * MiB;
constexpr size_t WS_PART = 6 * MiB;
constexpr size_t WS_LSE = 8 * MiB;
constexpr size_t WS_RINFO = 12 * MiB;
constexpr size_t WS_RW = 14 * MiB;
constexpr size_t WS_RR = 16 * MiB;
constexpr size_t WS_TOKREC = 18 * MiB;
constexpr size_t WS_PBF = 20 * MiB;
constexpr size_t WS_WGLU = 40 * MiB;
constexpr size_t WS_WQKV = 56 * MiB;
constexpr size_t WS_WO = 88 * MiB;
constexpr size_t WS_WPG = 96 * MiB;
constexpr size_t WS_WPP = 112 * MiB;
constexpr size_t WS_WGU = 116 * MiB;
constexpr size_t WS_WDN = 244 * MiB;
constexpr size_t WS_X = 308 * MiB;
constexpr size_t WS_U0 = WS_X, WS_G0 = WS_X + 64 * MiB;
constexpr size_t WS_SLOT = WS_X, WS_HID = WS_X + 128 * MiB;
constexpr size_t WS_Q = WS_X, WS_O = WS_X + 192 * MiB;
constexpr size_t WS_KB = 564 * MiB, WS_VB = 596 * MiB;
constexpr size_t WS_PP = 628 * MiB;
constexpr size_t WS_HA = 756 * MiB, WS_HB = 820 * MiB;
constexpr size_t WS_END = 884 * MiB;
constexpr int CW_BAR = 4096;
constexpr int CW_CNT = 16384;

__device__ __forceinline__ unsigned cvtpk(float lo, float hi) { f32x2 v = {lo, hi}; bf16x2_t b = __builtin_convertvector(v, bf16x2_t); return __builtin_bit_cast(unsigned, b); }
__device__ __forceinline__ float bflo(unsigned w) { return __uint_as_float(w << 16); }
__device__ __forceinline__ float bfhi(unsigned w) { return __uint_as_float(w & 0xffff0000u); }
__device__ __forceinline__ float wave_sum(float v) {
#pragma unroll
    for (int o = 1; o < 64; o <<= 1) v += __shfl_xor(v, o);
    return v;
}
__device__ __forceinline__ float sigmoidf_(float x) { return __builtin_amdgcn_rcpf(1.f + __builtin_amdgcn_exp2f(-1.4426950408889634f * x)); }
__device__ __forceinline__ float gelu_tanh(float x) { const float z = x * (2.3022082f + 0.1029432f * x * x); return x * __builtin_amdgcn_rcpf(1.f + __builtin_amdgcn_exp2f(-z)); }
#define LDS_WAIT() asm volatile("s_waitcnt lgkmcnt(0)" ::: "memory")

#define XB_TMO      128
#define XB_XCNT(j)  (256  + 64 * (j))
#define XB_XSUB(j)  (1280 + 64 * (j))
#define XB_XGEN(j)  (2304 + 64 * (j))
#define XB_TOP      3328
#define XB_TOPGEN   3392
#define XCD_BAR_WORDS 3456
#define XB_SPIN_CAP (1u << 18)
__device__ __forceinline__ unsigned xb_ld(unsigned* p)              { return __hip_atomic_load(p, __ATOMIC_RELAXED, __HIP_MEMORY_SCOPE_AGENT); }
__device__ __forceinline__ unsigned xb_add(unsigned* p, unsigned v) { return __hip_atomic_fetch_add(p, v, __ATOMIC_RELAXED, __HIP_MEMORY_SCOPE_AGENT); }
__device__ __forceinline__ unsigned xb_xcc_id() { return (unsigned)__builtin_amdgcn_s_getreg((3 << 11) | 20) & 0xFu; }
#define XB_SPIN(cond, bar) do { unsigned _sp = 0; while (cond) { __builtin_amdgcn_s_sleep(1); \
    if ((++_sp & 255u) == 0u) { if (xb_ld(&(bar)[XB_TMO])) break; if (_sp > XB_SPIN_CAP) { atomicAdd(&(bar)[XB_TMO], 1u); break; } } } } while (0)
struct XcdBarrier { unsigned* bar; unsigned x; volatile LAS unsigned* st; };
__device__ __forceinline__ XcdBarrier xcd_barrier_post(unsigned* bar, volatile LAS unsigned* st) {
    XcdBarrier b; b.bar = bar; b.x = xb_xcc_id(); b.st = st;
    if (threadIdx.x == 0) (void)xb_add(&bar[XB_XCNT(b.x)], 1u);
    return b;
}
__device__ __forceinline__ void xcd_barrier_complete(unsigned* bar, unsigned x, unsigned& nloc, unsigned& nx) {
    const unsigned G = gridDim.x * gridDim.y * gridDim.z;
    unsigned sum, cnt, mine, sp = 0u;
    for (;;) {
        sum = 0u; cnt = 0u; mine = 0u;
#pragma unroll
        for (unsigned j = 0; j < 16; ++j) { const unsigned c = xb_ld(&bar[XB_XCNT(j)]); sum += c; cnt += (c > 0u) ? 1u : 0u; mine = (j == x) ? c : mine; }
        if (sum == G) break;
        __builtin_amdgcn_s_sleep(1);
        if ((++sp & 255u) == 0u) { if (xb_ld(&bar[XB_TMO])) break; if (sp > XB_SPIN_CAP) { atomicAdd(&bar[XB_TMO], 1u); break; } }
    }
    nloc = mine > 0u ? mine : 1u; nx = cnt > 0u ? cnt : 1u;
}
__device__ __forceinline__ void xcd_barrier(const XcdBarrier& b) {
    asm volatile("s_waitcnt vmcnt(0)" ::: "memory");
    __syncthreads();
    if (threadIdx.x == 0) {
        unsigned* bar = b.bar;
        __builtin_amdgcn_s_waitcnt(0);
        unsigned nloc = b.st[0], nx = b.st[1];
        if (nloc == 0u) { xcd_barrier_complete(bar, b.x, nloc, nx); b.st[0] = nloc; b.st[1] = nx; }
        const unsigned old = xb_add(&bar[XB_XSUB(b.x)], 1u);
        const unsigned gen = old / nloc;
        if (old + 1u == (gen + 1u) * nloc) {
            __builtin_amdgcn_fence(__ATOMIC_RELEASE, "agent");
            asm volatile("s_waitcnt vmcnt(0)" ::: "memory");
            const unsigned og = xb_add(&bar[XB_TOP], 1u);
            const unsigned tg = og / nx;
            if (og + 1u == (tg + 1u) * nx) xb_add(&bar[XB_TOPGEN], 1u);
            else XB_SPIN(xb_ld(&bar[XB_TOPGEN]) == tg, bar);
            __builtin_amdgcn_fence(__ATOMIC_ACQUIRE, "agent");
            xb_add(&bar[XB_XGEN(b.x)], 1u);
            asm volatile("s_waitcnt vmcnt(0)" ::: "memory");
        } else {
            XB_SPIN(xb_ld(&bar[XB_XGEN(b.x)]) == gen, bar);
            __builtin_amdgcn_fence(__ATOMIC_ACQUIRE, "agent");
            asm volatile("s_waitcnt vmcnt(0)" ::: "memory");
        }
    }
    __syncthreads();
}

struct WUnit { const bf16* A; const bf16* B; const int* gidx; const int* info; int pm, pn, ex, nrows; };

namespace pg8 {
constexpr int BK = 64, HALF = 128, HTB = HALF * BK * 2, STAGE_BYTES = 8 * HTB;
__device__ __forceinline__ int lds_byte(int r, int c) { const int cc = c >> 3; return (r >> 3) * 1024 + ((((r & 7) << 3) | (cc ^ ((r >> 1) & 7))) << 4) + (c & 7) * 2; }
__device__ __forceinline__ void stage_rc(int b, int& R, int& C) { const int t = b >> 4, w = t >> 6, l = t & 63; R = 8 * w + (l >> 3); C = 8 * ((l & 7) ^ ((R >> 1) & 7)); }

template <bool GATHER>
__device__ __forceinline__ void unit_offsets(const WUnit& u, const int K, int R0, int C0, unsigned (&o)[2][2]) {
    if (GATHER) { int t = threadIdx.x; asm volatile("" : "+v"(t)); stage_rc(t * 16, R0, C0); }
#pragma unroll
    for (int h = 0; h < 2; ++h)
#pragma unroll
        for (int i = 0; i < 2; ++i) {
            int row = R0 + 64 * i + HALF * h;
            if (GATHER) row = (row < u.nrows) ? (u.gidx[row] >> 1) : 0;
            o[h][i] = ((unsigned)row * (unsigned)K + (unsigned)C0) * 2u;
        }
}

template <bool GATHER, bool ALIGN_EPI, bool FRESH_TID = false, class Epi, class Sched>
__device__ __forceinline__ void gemm_phase(LAS unsigned char* lds, const int K, const Sched& S, const Epi& E) {
    int tid_ = threadIdx.x; if (FRESH_TID) asm volatile("" : "+v"(tid_));
    const int tid = tid_, wid = __builtin_amdgcn_readfirstlane(tid >> 6), lane = tid & 63, wr = wid >> 2, wc = wid & 3, fr = lane & 15, fq = lane >> 4;
    const int nt = K / BK;
    int sR, sC; stage_rc(tid * 16, sR, sC);
    const int sRb = (sR & ~31) + (8 * ((sR & 15) >> 2) + 4 * ((sR >> 4) & 1) + (sR & 3));
    const unsigned voffB0 = (unsigned)(sRb * 64 + sC) * 2u; const unsigned r64 = 64u * (unsigned)K * 2u;
    const size_t kstep = (size_t)(BK * 2), kstepB = 8192;
    const size_t hstep = (size_t)HALF * K * 2;
    const unsigned ldsw = (unsigned)wid * 1024u;
    const int aoff0 = lds_byte(wr * 64 + fr, fq * 8), boff0 = lds_byte(wc * 32 + fr, fq * 8);
#define PG8_SA(b, h) (((b) * 2 + (h)) * HTB)
#define PG8_SB(b, h) ((4 + (b) * 2 + (h)) * HTB)
#define PG8_STAGE_B(bufoff, gbase) do { \
        __builtin_amdgcn_global_load_lds((const unsigned*)((const char*)(gbase) + voffB0), (LAS unsigned*)(lds + (bufoff) + ldsw), 16, 0, 0); \
        __builtin_amdgcn_global_load_lds((const unsigned*)((const char*)(gbase) + r64 + voffB0), (LAS unsigned*)(lds + (bufoff) + ldsw + 8192), 16, 0, 0); } while (0)
#define PG8_STAGE_A(bufoff, gbase, o0, o1) do { \
        __builtin_amdgcn_global_load_lds((const unsigned*)((const char*)(gbase) + (o0)), (LAS unsigned*)(lds + (bufoff) + ldsw), 16, 0, 0); \
        __builtin_amdgcn_global_load_lds((const unsigned*)((const char*)(gbase) + (o1)), (LAS unsigned*)(lds + (bufoff) + ldsw + 8192), 16, 0, 0); } while (0)
#define PG8_LDA(dst, b, h) do { int aoff1; asm volatile("v_xor_b32 %0, 64, %1" : "=v"(aoff1) : "v"(aoff0)); _Pragma("unroll") for (int m = 0; m < 4; ++m) _Pragma("unroll") for (int k = 0; k < 2; ++k) dst[m][k] = *(const LAS bf16x8*)(lds + PG8_SA(b, h) + (k ? aoff1 : aoff0) + m * 2048); } while (0)
#define PG8_LDB(dst, b, h) do { int boff1; asm volatile("v_xor_b32 %0, 64, %1" : "=v"(boff1) : "v"(boff0)); _Pragma("unroll") for (int n = 0; n < 2; ++n) _Pragma("unroll") for (int k = 0; k < 2; ++k) dst[n][k] = *(const LAS bf16x8*)(lds + PG8_SB(b, h) + (k ? boff1 : boff0) + n * 2048); } while (0)
#define PG8_MMA(ai, bj, At, Bt) do { __builtin_amdgcn_s_setprio(1); _Pragma("unroll") for (int m = 0; m < 4; ++m) _Pragma("unroll") for (int n = 0; n < 2; ++n) _Pragma("unroll") for (int k = 0; k < 2; ++k) \
        acc[ai][bj][m][n] = __builtin_amdgcn_mfma_f32_16x16x32_bf16(Bt[n][k], At[m][k], acc[ai][bj][m][n], 0, 0, 0); __builtin_amdgcn_s_setprio(0); } while (0)
#define PG8_WAIT_V(n) asm volatile("s_waitcnt vmcnt(" #n ")" ::: "memory")
#define PG8_WAIT_L(n) asm volatile("s_waitcnt lgkmcnt(" #n ")" ::: "memory")
#define PG8_BAR __builtin_amdgcn_s_barrier()
#define PG8_SCHED __builtin_amdgcn_sched_barrier(0)
    WUnit cur, nxt; int ui = 0;
    if (!S.next(0, cur)) return;
    unsigned oc[2][2];
    LAS unsigned char* pk = lds + STAGE_BYTES + tid * 32;
    unit_offsets<GATHER>(cur, K, sR, sC, oc);
    if constexpr (GATHER) { u32x4 q; q.x = oc[0][0]; q.y = oc[0][1]; q.z = oc[1][0]; q.w = oc[1][1]; *(LAS u32x4*)pk = q; }
    f32x4 acc[2][2][4][2];
#pragma unroll
    for (int a = 0; a < 2; ++a)
#pragma unroll
        for (int b = 0; b < 2; ++b)
#pragma unroll
            for (int m = 0; m < 4; ++m)
#pragma unroll
                for (int n = 0; n < 2; ++n) acc[a][b][m][n] = (f32x4){0.f, 0.f, 0.f, 0.f};
    bf16x8 At[4][2], B0[2][2], B1[2][2];
    const char* cA = (const char*)cur.A; const char* cB = (const char*)cur.B;
    PG8_STAGE_B(PG8_SB(0, 0), cB); PG8_STAGE_B(PG8_SB(0, 1), cB + hstep); PG8_STAGE_A(PG8_SA(0, 0), cA, oc[0][0], oc[0][1]); PG8_STAGE_A(PG8_SA(0, 1), cA, oc[1][0], oc[1][1]);
    if (wr == 1) PG8_BAR;
    PG8_WAIT_V(2); PG8_BAR;
    PG8_STAGE_B(PG8_SB(1, 0), cB + kstepB); PG8_STAGE_A(PG8_SA(1, 0), cA + kstep, oc[0][0], oc[0][1]); PG8_STAGE_B(PG8_SB(1, 1), cB + hstep + kstepB);
    PG8_WAIT_V(6); PG8_BAR;
    for (;;) {
        const bool has_next = S.next(ui + 1, nxt);
        const char* nA = has_next ? (const char*)nxt.A : cA; const char* nB = has_next ? (const char*)nxt.B : cB;
        if constexpr (GATHER) {
            unsigned on[2][2];
            if (has_next) unit_offsets<true>(nxt, K, sR, sC, on);
            else { const u32x4 q = *(const LAS u32x4*)pk; on[0][0] = q.x; on[0][1] = q.y; on[1][0] = q.z; on[1][1] = q.w; }
            u32x4 q; q.x = on[0][0]; q.y = on[0][1]; q.z = on[1][0]; q.w = on[1][1]; *(LAS u32x4*)(pk + 16) = q;
        }
#pragma clang loop unroll(disable)
        for (int t = 0; t < nt; t += 2) {
            const bool last = (t == nt - 2);
            const char* a1 = cA + (size_t)(t + 1) * kstep;
            const char* a2 = last ? nA : cA + (size_t)(t + 2) * kstep; const char* b2 = last ? nB : cB + (size_t)(t + 2) * kstepB;
            const char* a3 = a2 + kstep; const char* b3 = b2 + kstepB;
            const int nsel = (GATHER && last) ? 16 : 0;
#define PG8_OFF(h, base) (GATHER ? *(const LAS u32x2*)(pk + (base) + 8 * (h)) : (u32x2){oc[h][0], oc[h][1]})
            { const u32x2 o = PG8_OFF(1, 0);
              PG8_LDB(B0, 0, 0); PG8_LDB(B1, 0, 1); PG8_SCHED; PG8_LDA(At, 0, 0); PG8_STAGE_A(PG8_SA(1, 1), a1, o.x, o.y); }
            PG8_WAIT_V(8); PG8_WAIT_L(0); PG8_BAR; PG8_MMA(0, 0, At, B0); PG8_MMA(0, 1, At, B1); PG8_BAR; PG8_SCHED;
            { const u32x2 o = PG8_OFF(0, nsel);
              PG8_LDA(At, 0, 1); PG8_STAGE_B(PG8_SB(0, 0), b2); PG8_STAGE_B(PG8_SB(0, 1), b2 + hstep); PG8_STAGE_A(PG8_SA(0, 0), a2, o.x, o.y); }
            PG8_WAIT_V(8); PG8_WAIT_L(0); PG8_BAR; PG8_MMA(1, 0, At, B0); PG8_MMA(1, 1, At, B1); PG8_BAR; PG8_SCHED;
            { const u32x2 o = PG8_OFF(1, nsel);
              PG8_LDB(B0, 1, 0); PG8_LDB(B1, 1, 1); PG8_SCHED; PG8_LDA(At, 1, 0); PG8_STAGE_A(PG8_SA(0, 1), a2, o.x, o.y); }
            PG8_WAIT_V(8); PG8_WAIT_L(0); PG8_BAR; PG8_MMA(0, 0, At, B0); PG8_MMA(0, 1, At, B1); PG8_BAR; PG8_SCHED;
            { const u32x2 o = PG8_OFF(0, nsel);
              PG8_LDA(At, 1, 1); PG8_STAGE_B(PG8_SB(1, 0), b3); PG8_STAGE_B(PG8_SB(1, 1), b3 + hstep); PG8_STAGE_A(PG8_SA(1, 0), a3, o.x, o.y); }
            PG8_WAIT_V(8); PG8_WAIT_L(0); PG8_BAR; PG8_MMA(1, 0, At, B0); PG8_MMA(1, 1, At, B1); PG8_BAR; PG8_SCHED;
#undef PG8_OFF
        }
        if constexpr (ALIGN_EPI) { if (wr == 0) PG8_BAR; }
        { int fr_ = fr, fq_ = fq; asm volatile("" : "+v"(fr_), "+v"(fq_));
          E(acc, cur, wr, wc, fr_, fq_); }
        if (!has_next) break;
#pragma unroll
        for (int a = 0; a < 2; ++a)
#pragma unroll
            for (int b = 0; b < 2; ++b)
#pragma unroll
                for (int m = 0; m < 4; ++m)
#pragma unroll
                    for (int n = 0; n < 2; ++n) acc[a][b][m][n] = (f32x4){0.f, 0.f, 0.f, 0.f};
        cur = nxt; cA = nA; cB = nB; ++ui;
        if constexpr (GATHER) { const u32x4 q = *(const LAS u32x4*)(pk + 16); *(LAS u32x4*)pk = q; }
        if constexpr (ALIGN_EPI) { if (wr == 1) PG8_BAR; }
    }
    PG8_WAIT_V(0);
    if constexpr (!ALIGN_EPI) { if (wr == 0) PG8_BAR; }
    PG8_BAR;
#undef PG8_SA
#undef PG8_SB
#undef PG8_STAGE_A
#undef PG8_STAGE_B
#undef PG8_LDA
#undef PG8_LDB
#undef PG8_MMA
#undef PG8_WAIT_V
#undef PG8_WAIT_L
#undef PG8_BAR
#undef PG8_SCHED
}
}

struct DenseSched {
    const bf16* A; const bf16* B; int K, nM, nN, G, c;
    __device__ __forceinline__ bool next(int i, WUnit& u) const {
        const int nwg = nM * nN; const int Lx = i * G + c; if (Lx >= nwg) return false;
        int wgid = Lx; { const int q = nwg / 8, r = nwg % 8, xcd = wgid % 8, off = wgid / 8; wgid = (xcd < r ? xcd * (q + 1) : r * (q + 1) + (xcd - r) * q) + off; }
        const int nig = 4 * nN, gid = wgid / nig, fm = gid * 4, gsz = (nM - fm) < 4 ? (nM - fm) : 4;
        u.pm = fm + ((wgid % nig) % gsz); u.pn = (wgid % nig) / gsz;
        u.A = A + (size_t)u.pm * 256 * K; u.B = B + (size_t)u.pn * 256 * K; u.gidx = nullptr; u.info = nullptr; u.ex = 0; u.nrows = 256; return true;
    }
};
struct FillSched {
    const bf16* A; const bf16* B; int K, nM, nN, G, c, R;
    __device__ __forceinline__ bool next(int i, WUnit& u) const {
        const int Gp = G - R; if (c < R || Gp <= 0) return false;
        const int nwg = nM * nN; const int Lx = i * Gp + (c - R); if (Lx >= nwg) return false;
        u.pm = Lx / nN; u.pn = Lx - u.pm * nN;
        u.A = A + (size_t)u.pm * 256 * K; u.B = B + (size_t)u.pn * 256 * K; u.gidx = nullptr; u.info = nullptr; u.ex = 0; u.nrows = 256; return true;
    }
};
struct MoeSched {
    const bf16* A; const bf16* Bw; const int* rowinfo; const LAS int* pre; int K, NPN, G, c; size_t bstride; bool gather;
    __device__ __forceinline__ bool next(int i, WUnit& u) const {
        const int tot = pre[32] * NPN; int Lx = i * G + c; if (Lx >= tot) return false;
        { const int q = tot / 8, r = tot % 8, xcd = Lx % 8, off = Lx / 8; Lx = (xcd < r ? xcd * (q + 1) : r * (q + 1) + (xcd - r) * q) + off; }
        const int gm = Lx / NPN; u.pn = Lx - gm * NPN; int e = 0;
        for (int j = 1; j < 32; ++j) e += (pre[j] <= gm) ? 1 : 0;
        u.ex = e; const int mt = gm - pre[e]; u.pm = gm; const int ne = pre[40 + e]; const int left = ne - 256 * mt; u.nrows = left < 256 ? left : 256;
        u.B = Bw + (size_t)e * bstride + (size_t)u.pn * 256 * K;
        u.info = rowinfo + (size_t)e * T + 256 * mt;
        if (gather) { u.A = A; u.gidx = u.info; } else { u.A = A + (size_t)gm * 256 * K; u.gidx = nullptr; }
        return true;
    }
};

#define EPI_LOOP _Pragma("unroll") for (int ai = 0; ai < 2; ++ai) _Pragma("unroll") for (int m = 0; m < 4; ++m) _Pragma("unroll") for (int n = 0; n < 2; ++n)
#define EPI_RC const int r = 128 * ai + 64 * wr + 16 * m + fr; const int c = 32 * wc + 16 * n + 4 * fq;
typedef f32x4 AccT[2][2][4][2];

#ifndef EPI_SC1
#define EPI_SC1 0
#endif
__device__ __forceinline__ void st16(bf16* base, size_t elem, const u32x4 v) {
#if EPI_SC1
    const __amdgpu_buffer_rsrc_t r = __builtin_amdgcn_make_buffer_rsrc(base, 0, 0x7fffffff, 0x00020000);
    __builtin_amdgcn_raw_buffer_store_b128(v, r, (int)(unsigned)(elem * 2), 0, 16);
#else
    *(u32x4*)(base + elem) = v;
#endif
}
__device__ __forceinline__ u32x4 pack8(const f32x4 a, const f32x4 b) { u32x4 w; w.x = cvtpk(a[0], a[1]); w.y = cvtpk(a[2], a[3]); w.z = cvtpk(b[0], b[1]); w.w = cvtpk(b[2], b[3]); return w; }
__device__ __forceinline__ void unpack8(const u32x4 w, f32x4& a, f32x4& b) { a[0] = bflo(w.x); a[1] = bfhi(w.x); a[2] = bflo(w.y); a[3] = bfhi(w.y); b[0] = bflo(w.z); b[1] = bfhi(w.z); b[2] = bflo(w.w); b[3] = bfhi(w.w); }
struct EpiGLU {
    const float* x; const float* bias; bf16* out;
    __device__ __forceinline__ void operator()(const AccT& acc, const WUnit& u, int wr, int wc, int fr, int fq) const {
        const int col = 128 * u.pn + 32 * wc + 8 * fq;
        f32x4 bv[2], bg[2];
#pragma unroll
        for (int n = 0; n < 2; ++n) { bv[n] = *(const f32x4*)(bias + col + 4 * n); bg[n] = *(const f32x4*)(bias + 2048 + col + 4 * n); }
#pragma unroll
        for (int ai = 0; ai < 2; ++ai) {
            f32x4 xv[4][2];
#pragma unroll
            for (int m = 0; m < 4; ++m)
#pragma unroll
                for (int n = 0; n < 2; ++n) xv[m][n] = *(const f32x4*)(x + ((size_t)u.pm * 256 + 128 * ai + 64 * wr + 16 * m + fr) * D + col + 4 * n);
#pragma unroll
            for (int m = 0; m < 4; ++m) { const size_t row = (size_t)u.pm * 256 + 128 * ai + 64 * wr + 16 * m + fr; f32x4 o[2];
#pragma unroll
                for (int n = 0; n < 2; ++n) { const f32x4 v = acc[ai][0][m][n] + bv[n], g = acc[ai][1][m][n] + bg[n];
#pragma unroll
                    for (int i = 0; i < 4; ++i) o[n][i] = xv[m][n][i] + v[i] * sigmoidf_(g[i]); }
                st16(out, row * D + col, pack8(o[0], o[1])); }
        }
    }
};
struct EpiStore {
    bf16* out; int ldc;
    __device__ __forceinline__ void operator()(const AccT& acc, const WUnit& u, int wr, int wc, int fr, int fq) const {
#pragma unroll
        for (int ai = 0; ai < 2; ++ai)
#pragma unroll
            for (int m = 0; m < 4; ++m) { const size_t row = (size_t)u.pm * 256 + 128 * ai + 64 * wr + 16 * m + fr;
#pragma unroll
                for (int bj = 0; bj < 2; ++bj) st16(out, row * ldc + 256 * u.pn + 128 * bj + 32 * wc + 8 * fq, pack8(acc[ai][bj][m][0], acc[ai][bj][m][1])); }
    }
};
struct EpiGateUp {
    const float* rr; const float* rw; bf16* hid; const int* rinfo0;
    __device__ __forceinline__ void operator()(const AccT& acc, const WUnit& u, int wr, int wc, int fr, int fq) const {
        const size_t lbase = (size_t)(u.info - rinfo0);
#pragma unroll
        for (int ai = 0; ai < 2; ++ai)
#pragma unroll
            for (int mp = 0; mp < 2; ++mp) {
                float sr[2], sw[2];
#pragma unroll
                for (int mm = 0; mm < 2; ++mm) { const int r = 128 * ai + 64 * wr + 16 * (2 * mp + mm) + fr; const bool ok = r < u.nrows; sr[mm] = ok ? rr[lbase + r] : 0.f; sw[mm] = ok ? rw[lbase + r] : 0.f; }
#pragma unroll
                for (int mm = 0; mm < 2; ++mm) { const int m = 2 * mp + mm; const int r = 128 * ai + 64 * wr + 16 * m + fr; f32x4 o[2];
#pragma unroll
                    for (int n = 0; n < 2; ++n) { const f32x4 g = acc[ai][0][m][n] * sr[mm], up = acc[ai][1][m][n] * sr[mm];
#pragma unroll
                        for (int i = 0; i < 4; ++i) o[n][i] = (g[i] * sigmoidf_(g[i])) * up[i] * sw[mm]; }
                    st16(hid, ((size_t)u.pm * 256 + r) * 512 + 128 * u.pn + 32 * wc + 8 * fq, pack8(o[0], o[1])); }
            }
    }
};
struct EpiDown {
    bf16* slot;
    __device__ __forceinline__ void operator()(const AccT& acc, const WUnit& u, int wr, int wc, int fr, int fq) const {
        int inf[2][4];
#pragma unroll
        for (int ai = 0; ai < 2; ++ai)
#pragma unroll
            for (int m = 0; m < 4; ++m) { const int r = 128 * ai + 64 * wr + 16 * m + fr; inf[ai][m] = (r < u.nrows) ? u.info[r] : -1; }
#pragma unroll
        for (int ai = 0; ai < 2; ++ai)
#pragma unroll
            for (int m = 0; m < 4; ++m) { const int info = inf[ai][m];
                if (info >= 0) { const size_t tok = (size_t)(info >> 1), sl = (size_t)(info & 1);
                    const size_t o = (sl * T + tok) * D + 256 * u.pn + 32 * wc + 8 * fq;
#pragma unroll
                    for (int bj = 0; bj < 2; ++bj) st16(slot, o + 128 * bj, pack8(acc[ai][bj][m][0], acc[ai][bj][m][1])); } }
    }
};
struct EpiPLE {
    const bf16* hin; const bf16* pp; const float* rs; bf16* hout; float* part;
    __device__ __forceinline__ void operator()(const AccT& acc, const WUnit& u, int wr, int wc, int fr, int fq) const {
#pragma unroll
        for (int ai = 0; ai < 2; ++ai) {
            u32x4 hv[4][2], pv[4][2]; float sr[4];
#pragma unroll
            for (int m = 0; m < 4; ++m) { const size_t row = (size_t)u.pm * 256 + 128 * ai + 64 * wr + 16 * m + fr; sr[m] = rs[row];
#pragma unroll
                for (int bj = 0; bj < 2; ++bj) { const int col = 256 * u.pn + 128 * bj + 32 * wc + 8 * fq;
                    hv[m][bj] = *(const u32x4*)(hin + row * D + col); pv[m][bj] = *(const u32x4*)(pp + row * D + col); } }
#pragma unroll
            for (int m = 0; m < 4; ++m) { const size_t row = (size_t)u.pm * 256 + 128 * ai + 64 * wr + 16 * m + fr; float ss = 0.f;
#pragma unroll
                for (int bj = 0; bj < 2; ++bj) { const int col = 256 * u.pn + 128 * bj + 32 * wc + 8 * fq;
                    f32x4 h[2], p[2], o[2]; unpack8(hv[m][bj], h[0], h[1]); unpack8(pv[m][bj], p[0], p[1]);
#pragma unroll
                    for (int n = 0; n < 2; ++n) { const f32x4 av = acc[ai][bj][m][n];
#pragma unroll
                        for (int i = 0; i < 4; ++i) { o[n][i] = h[n][i] + sigmoidf_(sr[m] * av[i]) * p[n][i]; ss += o[n][i] * o[n][i]; } }
                    st16(hout, row * D + col, pack8(o[0], o[1])); }
                ss += __shfl_xor(ss, 16); ss += __shfl_xor(ss, 32);
                if (fq == 0) part[row * 32 + 4 * u.pn + wc] = ss; }
        }
    }
};
struct EpiQKV {
    const float* part; const float* rope; bf16* q; bf16* kb; bf16* vb;
    __device__ __forceinline__ void operator()(const AccT& acc, const WUnit& u, int wr, int wc, int fr, int fq) const {
        const bool rot = u.pn < 28;
        const int c = 32 * wc + 8 * fq, hsel = c >> 6, d = c & 63;
        const unsigned* rp = (const unsigned*)rope;
#pragma unroll
        for (int ai = 0; ai < 2; ++ai) {
            f32x4 p0[4], p1[4]; u32x4 cs[4][2];
#pragma unroll
            for (int m = 0; m < 4; ++m) { const size_t row = (size_t)u.pm * 256 + 128 * ai + 64 * wr + 16 * m + fr; const int pos = (int)(row & (SEQ - 1));
                p0[m] = *(const f32x4*)(part + row * 32 + 8 * fq); p1[m] = *(const f32x4*)(part + row * 32 + 8 * fq + 4);
                if (rot) { cs[m][0] = *(const u32x4*)(rp + (size_t)pos * 64 + d); cs[m][1] = *(const u32x4*)(rp + (size_t)pos * 64 + d + 4); }
                else { cs[m][0] = (u32x4){0x3f80u, 0x3f80u, 0x3f80u, 0x3f80u}; cs[m][1] = cs[m][0]; } }
#pragma unroll
            for (int m = 0; m < 4; ++m) { const size_t row = (size_t)u.pm * 256 + 128 * ai + 64 * wr + 16 * m + fr;
                float ss = ((p0[m][0] + p0[m][1]) + (p0[m][2] + p0[m][3])) + ((p1[m][0] + p1[m][1]) + (p1[m][2] + p1[m][3]));
                ss += __shfl_xor(ss, 16); ss += __shfl_xor(ss, 32);
                const float sr = rsqrtf(ss * (1.f / D) + EPS);
                f32x4 o1[2], o2[2];
#pragma unroll
                for (int n = 0; n < 2; ++n) { const f32x4 a1 = acc[ai][0][m][n] * sr, a2 = acc[ai][1][m][n] * sr;
                    if (rot) {
#pragma unroll
                        for (int i = 0; i < 4; ++i) { const unsigned w = cs[m][n][i]; const float co = bflo(w), si = bfhi(w); o1[n][i] = a1[i] * co - a2[i] * si; o2[n][i] = a2[i] * co + a1[i] * si; }
                    } else { o1[n] = a1; o2[n] = a2; } }
                if (u.pn < 24) { const size_t o = row * 6144 + (size_t)(2 * u.pn + hsel) * 128 + d; st16(q, o, pack8(o1[0], o1[1])); st16(q, o + 64, pack8(o2[0], o2[1])); }
                else if (rot) { const size_t o = row * 1024 + (size_t)(2 * (u.pn - 24) + hsel) * 128 + d; st16(kb, o, pack8(o1[0], o1[1])); st16(kb, o + 64, pack8(o2[0], o2[1])); }
                else { const size_t o = row * 1024 + 256 * (u.pn - 28) + c; st16(vb, o, pack8(o1[0], o1[1])); st16(vb, o + 128, pack8(o2[0], o2[1])); }
            }
        }
    }
};
struct EpiResAdd {
    const bf16* hin; bf16* hout;
    __device__ __forceinline__ void operator()(const AccT& acc, const WUnit& u, int wr, int wc, int fr, int fq) const {
        u32x4 hv[2][4][2];
#pragma unroll
        for (int ai = 0; ai < 2; ++ai)
#pragma unroll
            for (int m = 0; m < 4; ++m)
#pragma unroll
                for (int bj = 0; bj < 2; ++bj) hv[ai][m][bj] = *(const u32x4*)(hin + ((size_t)u.pm * 256 + 128 * ai + 64 * wr + 16 * m + fr) * D + 256 * u.pn + 128 * bj + 32 * wc + 8 * fq);
#pragma unroll
        for (int ai = 0; ai < 2; ++ai)
#pragma unroll
            for (int m = 0; m < 4; ++m) { const size_t row = (size_t)u.pm * 256 + 128 * ai + 64 * wr + 16 * m + fr;
#pragma unroll
                for (int bj = 0; bj < 2; ++bj) { f32x4 h[2]; unpack8(hv[ai][m][bj], h[0], h[1]);
                    st16(hout, row * D + 256 * u.pn + 128 * bj + 32 * wc + 8 * fq, pack8(h[0] + acc[ai][bj][m][0], h[1] + acc[ai][bj][m][1])); } }
    }
};

struct Args { const float* in[31]; float* out; unsigned char* ws; int ph_lo, ph_hi; };

constexpr int CV_KBW = 4, CV_NBW = 2;
struct TrDesc { const float* W; bf16* dst; const float* gain; int ldn, k0, n0, K, drow0; float scale; };
enum { MAP_PLAIN = 0, MAP_HALF0 = 1, MAP_HALF1 = 2, MAP_ROPE = 3 };
__device__ __forceinline__ int map_row(int mode, int n0) {
    if (mode == MAP_PLAIN) return n0;
    if (mode == MAP_HALF0) return 256 * (n0 >> 7) + (n0 & 127);
    if (mode == MAP_HALF1) return 256 * (n0 >> 7) + 128 + (n0 & 127);
    const int head = n0 >> 7, d = n0 & 127; return 256 * (head >> 1) + 128 * (d >> 6) + 64 * (head & 1) + (d & 63);
}
__device__ __forceinline__ TrDesc mk_desc(const float* W, int ldn, int K, int ncols, bf16* dst, int drow_base, int mode, const float* gain, float scale, int it) {
    const int nblk = ncols >> 6; const int grp = it >> 3, j = it & 7, ngn = nblk / CV_NBW, kg = grp / ngn, ng = grp - kg * ngn;
    const int kb = kg * CV_KBW + j / CV_NBW, nb = ng * CV_NBW + j % CV_NBW;
    TrDesc d; d.W = W; d.dst = dst; d.gain = gain; d.ldn = ldn; d.k0 = 64 * kb; d.n0 = 64 * nb; d.K = K; d.drow0 = drow_base + map_row(mode, 64 * nb); d.scale = scale; return d;
}
__device__ __forceinline__ void tr_load(const TrDesc& d, f32x4 (&v)[16], int lane) {
    const int kq = lane >> 4, n4 = lane & 15;
#pragma unroll
    for (int j = 0; j < 16; ++j) v[j] = __builtin_nontemporal_load((const f32x4*)(d.W + (size_t)(d.k0 + kq + 4 * j) * d.ldn + d.n0 + 4 * n4));
}
__device__ __forceinline__ void tr_finish(const TrDesc& d, const f32x4 (&v)[16], LAS unsigned char* scr, int lane) {
    const int kq = lane >> 4, n4 = lane & 15;
#pragma unroll
    for (int j = 0; j < 16; ++j) { float g = d.scale; if (d.gain) g *= d.gain[d.k0 + kq + 4 * j];
        u32x2 w; w.x = cvtpk(v[j][0] * g, v[j][1] * g); w.y = cvtpk(v[j][2] * g, v[j][3] * g);
        *(LAS u32x2*)(scr + (kq + 4 * j) * 192 + n4 * 8) = w; }
    LDS_WAIT();
    const int G4 = lane >> 4, li = lane & 15, q = li >> 2, p = li & 3;
    u32x2 t[16];
#pragma unroll
    for (int r = 0; r < 16; ++r) t[r] = __builtin_bit_cast(u32x2, __builtin_amdgcn_ds_read_tr16_b64_v4i16((LAS s16x4*)(scr + (4 * r + q) * 192 + (16 * G4 + 4 * p) * 2)));
    bf16* o = d.dst + ((size_t)(d.drow0 >> 6) * (d.K >> 6) + (d.k0 >> 6)) * 4096 + (16 * G4 + li) * 64;
#pragma unroll
    for (int c = 0; c < 8; ++c) { u32x4 w; w.x = t[2 * c].x; w.y = t[2 * c].y; w.z = t[2 * c + 1].x; w.w = t[2 * c + 1].y; *(u32x4*)(o + 8 * c) = w; }
    LDS_WAIT();
}
struct MoeItems {
    const float* wg; const float* wu; const float* wd; const float* gain; bf16* WGU; bf16* WDN;
    __device__ __forceinline__ int count() const { return 32 * 768; }
    __device__ __forceinline__ TrDesc operator()(int it) const {
        const int e = it / 768, rem = it - e * 768, kind = rem >> 8, sub = rem & 255;
        if (kind == 0)      return mk_desc(wg + (size_t)e * 2048 * 512, 512, 2048, 512, WGU + (size_t)e * 1024 * 2048, 0, MAP_HALF0, gain, 1.f, sub);
        else if (kind == 1) return mk_desc(wu + (size_t)e * 2048 * 512, 512, 2048, 512, WGU + (size_t)e * 1024 * 2048, 0, MAP_HALF1, gain, 1.f, sub);
        return mk_desc(wd + (size_t)e * 512 * 2048, 2048, 512, 2048, WDN + (size_t)e * 2048 * 512, 0, MAP_PLAIN, nullptr, 1.f, sub);
    }
};
struct DenseItems {
    const Args* a; unsigned char* ws;
    __device__ __forceinline__ int count() const { return 9472; }
    __device__ __forceinline__ TrDesc operator()(int it) const {
        const float* const* in = a->in;
        bf16* WGLU = (bf16*)(ws + WS_WGLU); bf16* WQKV = (bf16*)(ws + WS_WQKV); bf16* WO = (bf16*)(ws + WS_WO); bf16* WPG = (bf16*)(ws + WS_WPG); bf16* WPP = (bf16*)(ws + WS_WPP);
        if (it < 1024) return mk_desc(in[11], 4096, 2048, 2048, WGLU, 0, MAP_HALF0, nullptr, 1.f, it); it -= 1024;
        if (it < 1024) return mk_desc(in[11] + 2048, 4096, 2048, 2048, WGLU, 0, MAP_HALF1, nullptr, 1.f, it); it -= 1024;
        if (it < 3072) return mk_desc(in[17], 6144, 2048, 6144, WQKV, 0, MAP_ROPE, in[16], 0.08838834764831845f, it); it -= 3072;
        if (it < 512) return mk_desc(in[14], 1024, 2048, 1024, WQKV, 6144, MAP_ROPE, in[13], 1.f, it); it -= 512;
        if (it < 512) return mk_desc(in[15], 1024, 2048, 1024, WQKV, 7168, MAP_PLAIN, in[13], 1.f, it); it -= 512;
        if (it < 1024) return mk_desc(in[18], 2048, 2048, 2048, WO, 0, MAP_PLAIN, nullptr, 1.f, it); it -= 1024;
        if (it < 1024) return mk_desc(in[28], 2048, 2048, 2048, WPG, 0, MAP_PLAIN, in[27], 1.f, it); it -= 1024;
        if (it < 128) return mk_desc(in[29], 2048, 256, 2048, WPP, 0, MAP_PLAIN, nullptr, 1.f, it); it -= 128;
        if (it < 1024) return mk_desc(in[28] + (size_t)2048 * 2048, 2048, 2048, 2048, WPG + (size_t)2048 * 2048, 0, MAP_PLAIN, in[27] + D, 1.f, it); it -= 1024;
        return mk_desc(in[29] + (size_t)256 * 2048, 2048, 256, 2048, WPP + (size_t)2048 * 256, 0, MAP_PLAIN, nullptr, 1.f, it);
    }
};
template <class Items>
__device__ __forceinline__ void run_items(const Items& I, int gw, int NGW, LAS unsigned char* scr, int lane) {
    const int n = I.count(); int it = gw; if (it >= n) return;
    TrDesc cur = I(it); f32x4 v[16]; tr_load(cur, v, lane);
    for (;;) {
        const int nx = it + NGW; const bool more = nx < n;
        TrDesc nd = cur; f32x4 w[16];
        if (more) { nd = I(nx); tr_load(nd, w, lane); }
        tr_finish(cur, v, scr, lane);
        if (!more) break;
#pragma unroll
        for (int j = 0; j < 16; ++j) v[j] = w[j];
        cur = nd; it = nx;
    }
}
__device__ __forceinline__ void moe_weights(const Args& a, int layer, int gw, int NGW, LAS unsigned char* scr, int lane) {
    MoeItems I{a.in[24] + (size_t)layer * 32 * 2048 * 512, a.in[25] + (size_t)layer * 32 * 2048 * 512, a.in[26] + (size_t)layer * 32 * 512 * 2048, a.in[19] + layer * D, (bf16*)(a.ws + WS_WGU), (bf16*)(a.ws + WS_WDN)};
    run_items(I, gw, NGW, scr, lane);
}

__device__ __forceinline__ void p0_prologue(const Args& a, LAS unsigned char* lds, int vcu, int G) {
    const int tid = threadIdx.x, lane = tid & 63, wave = __builtin_amdgcn_readfirstlane(tid >> 6);
    LAS unsigned char* scr = lds + wave * 16384;
    const int gw = vcu * NWAVES + wave, NGW = G * NWAVES;
    unsigned char* ws = a.ws;
    { DenseItems I{&a, ws}; run_items(I, gw, NGW, scr, lane); }
    {
        const float* x = a.in[0]; const float* g = a.in[2]; bf16* U0 = (bf16*)(ws + WS_U0);
        for (int row = gw; row < T; row += NGW) {
            const float* xr = x + (size_t)row * D; f32x4 v[4][2]; float ss = 0.f;
#pragma unroll
            for (int j = 0; j < 4; ++j) { v[j][0] = __builtin_nontemporal_load((const f32x4*)(xr + j * 512 + lane * 8)); v[j][1] = __builtin_nontemporal_load((const f32x4*)(xr + j * 512 + lane * 8 + 4));
#pragma unroll
                for (int h = 0; h < 2; ++h) ss += (v[j][h][0] * v[j][h][0] + v[j][h][1] * v[j][h][1]) + (v[j][h][2] * v[j][h][2] + v[j][h][3] * v[j][h][3]); }
            const float r = rsqrtf(wave_sum(ss) * (1.f / D) + EPS);
#pragma unroll
            for (int j = 0; j < 4; ++j) { const f32x4 g0 = *(const f32x4*)(g + j * 512 + lane * 8), g1 = *(const f32x4*)(g + j * 512 + lane * 8 + 4);
                u32x4 w; w.x = cvtpk(v[j][0][0] * r * g0[0], v[j][0][1] * r * g0[1]); w.y = cvtpk(v[j][0][2] * r * g0[2], v[j][0][3] * r * g0[3]);
                w.z = cvtpk(v[j][1][0] * r * g1[0], v[j][1][1] * r * g1[1]); w.w = cvtpk(v[j][1][2] * r * g1[2], v[j][1][3] * r * g1[3]);
                *(u32x4*)(U0 + (size_t)row * D + j * 512 + lane * 8) = w; }
        }
    }
    const int gt = vcu * NTHR + tid, NGT = G * NTHR;
    {
        const float* p = a.in[1]; bf16* PB = (bf16*)(ws + WS_PBF);
        for (int i = gt; i < 2 * T * 256 / 8; i += NGT) { const f32x4 v0 = __builtin_nontemporal_load((const f32x4*)(p + (size_t)i * 8)), v1 = __builtin_nontemporal_load((const f32x4*)(p + (size_t)i * 8 + 4));
            u32x4 w; w.x = cvtpk(v0[0], v0[1]); w.y = cvtpk(v0[2], v0[3]); w.z = cvtpk(v1[0], v1[1]); w.w = cvtpk(v1[2], v1[3]); *(u32x4*)(PB + (size_t)i * 8) = w; }
    }
    {
        float* rope = (float*)(ws + WS_ROPE);
        for (int i = gt; i < SEQ * 64; i += NGT) { const int pos = i >> 6, d = i & 63;
            const float inv = __builtin_amdgcn_exp2f(-(float)d * (13.287712379549449f / 64.f));
            float xrev = (float)pos * inv * 0.15915494309189535f; xrev -= floorf(xrev);
            ((unsigned*)rope)[i] = cvtpk(__builtin_amdgcn_cosf(xrev), __builtin_amdgcn_sinf(xrev)); }
    }
    {
        bf16* S5B = (bf16*)(ws + WS_S5B); bf16* S5C = (bf16*)(ws + WS_S5C); float* LB = (float*)(ws + WS_LB);
        for (int i = gt; i < 128 * 64; i += NGT) { const int g = i >> 6, p = i & 63;
            const float are = a.in[3][i], aim = a.in[4][i], dt = __expf(a.in[5][g]);
            const float mag = __expf(are * dt); float xrev = aim * dt * 0.15915494309189535f; xrev -= floorf(xrev);
            const float lre = mag * __builtin_amdgcn_cosf(xrev), lim = mag * __builtin_amdgcn_sinf(xrev);
            LB[2 * i] = lre; LB[2 * i + 1] = lim;
            const float nre = lre - 1.f, nim = lim, den = 1.f / (are * are + aim * aim);
            const float cre = (nre * are + nim * aim) * den, cim = (nim * are - nre * aim) * den;
            for (int ch = 0; ch < 16; ++ch) { const float bre = a.in[6][(size_t)i * 16 + ch], bim = a.in[7][(size_t)i * 16 + ch];
                const float vre = cre * bre - cim * bim, vim = cre * bim + cim * bre;
                const int hi = ch >> 3, jj = ch & 7;
#pragma unroll
                for (int ri = 0; ri < 2; ++ri) { const int col = 2 * p + ri, j = col >> 5, ln = (col & 31) + 32 * hi;
                    S5B[(((size_t)g * 4 + j) * 64 + ln) * 8 + jj] = (bf16)(cvtpk(ri ? vim : vre, 0.f) & 0xffffu); } }
#pragma unroll
            for (int ri = 0; ri < 2; ++ri) { const int k = 2 * p + ri, kk = k >> 4, hi = (k >> 3) & 1, jj = k & 7;
                for (int n = 0; n < 32; ++n) { float v = 0.f; if (n < 16) v = ri ? -a.in[9][((size_t)g * 16 + n) * 64 + p] : a.in[8][((size_t)g * 16 + n) * 64 + p];
                    S5C[(((size_t)g * 8 + kk) * 64 + (n + 32 * hi)) * 8 + jj] = (bf16)(cvtpk(v, 0.f) & 0xffffu); } }
        }
        bf16* S5D = (bf16*)(ws + WS_S5D);
        for (int i = gt; i < 128 * 64; i += NGT) { const int g = i >> 6, ln = i & 63, n = ln & 31, hi = ln >> 5;
#pragma unroll
            for (int jj = 0; jj < 8; ++jj) { const int k = 8 * hi + jj; const float v = (n == k && n < 16) ? a.in[10][g * 16 + n] : 0.f; S5D[(size_t)i * 8 + jj] = (bf16)(cvtpk(v, 0.f) & 0xffffu); } }
    }
    {
        bf16* WR = (bf16*)(ws + WS_WR);
        for (int i = gt; i < 2 * 48 * 2048; i += NGT) { const int l = i / (48 * 2048), rem = i - l * 48 * 2048, n = rem >> 11, k = rem & 2047;
            float w = 0.f; if (n < 4) w = a.in[20][((size_t)l * 2048 + k) * 4 + n]; else if (n < 36) w = a.in[22][((size_t)l * 2048 + k) * 32 + (n - 4)];
            w *= a.in[19][l * D + k];
            const unsigned hi = cvtpk(w, 0.f) & 0xffffu; const float lo = w - __uint_as_float(hi << 16);
            WR[((size_t)(l * 2 + 0) * 48 + n) * 2048 + k] = (bf16)hi; WR[((size_t)(l * 2 + 1) * 48 + n) * 2048 + k] = (bf16)(cvtpk(lo, 0.f) & 0xffffu); }
    }
}

__device__ __forceinline__ void s5_phase(const Args& a, LAS unsigned char* lds, int vcu, int G) {
    const int tid = threadIdx.x, lane = tid & 63, wave = __builtin_amdgcn_readfirstlane(tid >> 6), hi = lane >> 5, ql = lane & 31;
    unsigned char* ws = a.ws;
    const bf16* U0 = (const bf16*)(ws + WS_U0); bf16* G0 = (bf16*)(ws + WS_G0);
    const int pr = wave & 3; const bool producer = wave < 4;
    LAS unsigned char* pbase = lds + pr * 36864;
    LAS float* BU = (LAS float*)pbase;
    LAS unsigned* SSb = (LAS unsigned*)(pbase + 16384);
    volatile LAS unsigned* flg = (volatile LAS unsigned*)(pbase + 16384 + 17408);
    for (int item = vcu; item < 256; item += G) {
        const int b = item >> 5, g = 4 * (item & 31) + pr;
        const size_t base = (size_t)b * SEQ * D + (size_t)g * 16;
        __syncthreads();
        if (lane < 4 && producer) flg[lane] = 0u;
        __syncthreads();
        if (producer) {
            bf16x8 bm[4];
#pragma unroll
            for (int j = 0; j < 4; ++j) bm[j] = *(const bf16x8*)((const bf16*)(ws + WS_S5B) + (((size_t)g * 4 + j) * 64 + lane) * 8);
            const f32x2 lam = *(const f32x2*)((const float*)(ws + WS_LB) + ((size_t)g * 64 + lane) * 2);
            float sre = 0.f, sim = 0.f;
            bf16x8 ua = *(const bf16x8*)(U0 + base + (size_t)ql * D + 8 * hi), ub = *(const bf16x8*)(U0 + base + (size_t)(32 + ql) * D + 8 * hi);
            auto pbody = [&](const int blk, bf16x8& ur) {
                const int t0 = blk * 32, buf = blk & 1;
                const bf16x8 uf = ur;
#pragma unroll
                for (int j = 0; j < 4; ++j) {
                    f32x16 acc;
#pragma unroll
                    for (int i = 0; i < 16; ++i) acc[i] = 0.f;
                    acc = __builtin_amdgcn_mfma_f32_32x32x16_bf16(uf, bm[j], acc, 0, 0, 0);
#pragma unroll
                    for (int i = 0; i < 16; ++i) BU[((i & 3) + 8 * (i >> 2) + 4 * hi) * 128 + 32 * j + ql] = acc[i];
                }
                { const int tn = (blk < 62) ? t0 + 64 : t0; ur = *(const bf16x8*)(U0 + base + (size_t)(tn + ql) * D + 8 * hi); }
                LDS_WAIT();
                f32x2 bu[32];
#pragma unroll
                for (int t = 0; t < 32; ++t) bu[t] = *(const LAS f32x2*)(BU + t * 128 + 2 * lane);
                if (blk >= 2) { while (flg[2 + buf] < (unsigned)(blk - 1)) __builtin_amdgcn_s_sleep(1); }
                asm volatile("" ::: "memory");
                LAS unsigned* SS = SSb + buf * (32 * 68);
#pragma unroll
                for (int t = 0; t < 32; ++t) {
                    const float nre = lam.x * sre - lam.y * sim + bu[t].x, nim = lam.x * sim + lam.y * sre + bu[t].y;
                    sre = nre; sim = nim;
                    SS[t * 68 + lane] = cvtpk(sre, sim);
                }
                LDS_WAIT();
                if (lane == 0) flg[buf] = (unsigned)(blk + 1);
            };
#pragma clang loop unroll(disable)
            for (int blk = 0; blk < 64; blk += 2) { pbody(blk, ua); pbody(blk + 1, ub); }
        } else {
            bf16x8 cm[8], dm;
#pragma unroll
            for (int kk = 0; kk < 8; ++kk) cm[kk] = *(const bf16x8*)((const bf16*)(ws + WS_S5C) + (((size_t)g * 8 + kk) * 64 + lane) * 8);
            dm = *(const bf16x8*)((const bf16*)(ws + WS_S5D) + ((size_t)g * 64 + lane) * 8);
            bf16x8 ufn = *(const bf16x8*)(U0 + base + (size_t)ql * D + 8 * hi);
            bf16x8 bsel[2];
#pragma unroll
            for (int s2 = 0; s2 < 2; ++s2) { const int jj = ql - 16 * s2 - 8 * hi; u32x4 w;
                w.x = jj == 0 ? 0x3f80u : jj == 1 ? 0x3f800000u : 0u; w.y = jj == 2 ? 0x3f80u : jj == 3 ? 0x3f800000u : 0u;
                w.z = jj == 4 ? 0x3f80u : jj == 5 ? 0x3f800000u : 0u; w.w = jj == 6 ? 0x3f80u : jj == 7 ? 0x3f800000u : 0u; bsel[s2] = __builtin_bit_cast(bf16x8, w); }
            const int cri = (ql & 3) + 4 * (ql >> 3) + 32 * ((ql >> 2) & 1);
            __builtin_amdgcn_s_waitcnt(0x0F70);
            auto body = [&](const int blk, const bf16x8& uf, bf16x8& ufnx, const bool cv) {
                const int t0 = blk * 32, buf = blk & 1;
                { const int tn = (blk < 63) ? t0 + 32 : t0; ufnx = *(const bf16x8*)(U0 + base + (size_t)(tn + ql) * D + 8 * hi); }
                f32x4 cvv[2][2][2]; float cg[2] = {1.f, 1.f}; bf16* cdst = nullptr; int cK = 0;
                if (cv) {
                    const int q = (3 * (blk >> 2) + (blk & 3)) * 1024 + item * 4 + pr;
                    const int e = q / 1536, r = q - e * 1536, kind = r >> 9, sub = r & 511;
                    const float* src; int ldn; const float* gp = a.in[19];
                    if (kind < 2) { const int kp = sub >> 4, n0 = 32 * (sub & 15);
                        src = a.in[24 + kind] + (size_t)e * 2048 * 512 + (size_t)(64 * kp) * 512 + n0; ldn = 512; cK = 2048;
                        { const int row0 = 256 * (n0 >> 7) + 128 * kind + (n0 & 127);
                          cdst = (bf16*)(ws + WS_WGU) + (size_t)e * 1024 * 2048 + (size_t)((row0 >> 6) * 32 + kp) * 4096 + (row0 & 63) * 64; }
                        gp += 64 * kp;
                    } else { const int kp = sub >> 6, n0 = 32 * (sub & 63);
                        src = a.in[26] + (size_t)e * 512 * 2048 + (size_t)(64 * kp) * 2048 + n0; ldn = 2048; cK = 512;
                        cdst = (bf16*)(ws + WS_WDN) + (size_t)e * 2048 * 512 + (size_t)((n0 >> 6) * 8 + kp) * 4096 + (n0 & 63) * 64; }
                    { const float g0 = gp[cri], g1 = gp[cri + 16]; cg[0] = kind < 2 ? g0 : 1.f; cg[1] = kind < 2 ? g1 : 1.f; }
#pragma unroll
                    for (int t = 0; t < 2; ++t)
#pragma unroll
                        for (int s2 = 0; s2 < 2; ++s2) { const float* p = src + (size_t)(cri + 16 * t) * ldn + 16 * s2 + 8 * hi;
                            cvv[t][s2][0] = *(const f32x4*)p; cvv[t][s2][1] = *(const f32x4*)(p + 4); }
                }
                while (flg[buf] < (unsigned)(blk + 1)) __builtin_amdgcn_s_sleep(1);
                asm volatile("" ::: "memory");
                const LAS unsigned* SS = SSb + buf * (32 * 68);
                bf16x8 sf[8];
#pragma unroll
                for (int kk = 0; kk < 8; ++kk) sf[kk] = *(const LAS bf16x8*)(SS + ql * 68 + 8 * kk + 4 * hi);
                LDS_WAIT();
                if (lane == 0) flg[2 + buf] = (unsigned)(blk + 1);
                f32x16 y;
#pragma unroll
                for (int i = 0; i < 16; ++i) y[i] = 0.f;
#pragma unroll
                for (int kk = 0; kk < 8; ++kk) y = __builtin_amdgcn_mfma_f32_32x32x16_bf16(sf[kk], cm[kk], y, 0, 0, 0);
                y = __builtin_amdgcn_mfma_f32_32x32x16_bf16(uf, dm, y, 0, 0, 0);
                LAS unsigned short* YT = (LAS unsigned short*)(pbase + 16384 + 17408 + 64 + (blk & 1) * 1024);
                if (ql < 16) {
#pragma unroll
                    for (int i = 0; i < 16; ++i) { const int tl = (i & 3) + 8 * (i >> 2) + 4 * hi; YT[tl * 16 + ql] = (unsigned short)(cvtpk(gelu_tanh(y[i]), 0.f) & 0xffffu); }
                }
                LDS_WAIT();
                { const u32x4 w0 = *(const LAS u32x4*)(YT + lane * 8);
                    bf16* o = G0 + base + (size_t)(t0 + (lane >> 1)) * D + 8 * (lane & 1); *(u32x4*)o = w0; }
                LDS_WAIT();
                if (cv) {
#pragma unroll
                    for (int t = 0; t < 2; ++t) { f32x16 ca;
#pragma unroll
                        for (int i = 0; i < 16; ++i) ca[i] = 0.f;
#pragma unroll
                        for (int s2 = 0; s2 < 2; ++s2) ca = __builtin_amdgcn_mfma_f32_32x32x16_bf16(__builtin_bit_cast(bf16x8, pack8(cvv[t][s2][0] * cg[t], cvv[t][s2][1] * cg[t])), bsel[s2], ca, 0, 0, 0);
                        bf16* o = cdst + ql * 64 + 32 * hi + 16 * t;
                        *(u32x4*)o = pack8((f32x4){ca[0], ca[1], ca[2], ca[3]}, (f32x4){ca[4], ca[5], ca[6], ca[7]});
                        *(u32x4*)(o + 8) = pack8((f32x4){ca[8], ca[9], ca[10], ca[11]}, (f32x4){ca[12], ca[13], ca[14], ca[15]}); }
                }
            };
            bf16x8 ufa = ufn, ufb = ufn;
#pragma clang loop unroll(disable)
            for (int blk = 0; blk < 64; blk += 4) { body(blk, ufa, ufb, true); body(blk + 1, ufb, ufa, true); body(blk + 2, ufa, ufb, true); body(blk + 3, ufb, ufa, false); }
        }
    }
}

__device__ __forceinline__ void router_phase(const Args& a, int layer, const bf16* H, LAS unsigned char* lds, int vcu, int G) {
    const int tid = threadIdx.x, lane = tid & 63, wave = __builtin_amdgcn_readfirstlane(tid >> 6), fr = lane & 15, fq = lane >> 4;
    unsigned char* ws = a.ws;
    const bf16* WR = (const bf16*)(ws + WS_WR) + (size_t)layer * 2 * 48 * 2048;
    LAS float* red = (LAS float*)lds;
    LAS float* fin = (LAS float*)(lds + 106496);
    const float* gb = a.in[21] + layer * 4; const float* eb = a.in[23] + layer * 32;
    for (int item = vcu; item < T / 64; item += G) {
        const int t0 = item * 64;
        f32x4 acc[4][3];
#pragma unroll
        for (int mt = 0; mt < 4; ++mt)
#pragma unroll
            for (int i = 0; i < 3; ++i) acc[mt][i] = (f32x4){0.f, 0.f, 0.f, 0.f};
        float ss[4] = {0.f, 0.f, 0.f, 0.f};
        const bf16* hp = H + (size_t)(t0 + fr) * D + wave * 256 + 8 * fq;
        const bf16* wp = WR + (size_t)fr * 2048 + wave * 256 + 8 * fq;
#pragma unroll 2
        for (int ks = 0; ks < 8; ++ks) {
            bf16x8 af[4], wh[3], wl[3];
#pragma unroll
            for (int mt = 0; mt < 4; ++mt) af[mt] = *(const bf16x8*)(hp + (size_t)mt * 16 * D + ks * 32);
#pragma unroll
            for (int nt = 0; nt < 3; ++nt) { wh[nt] = *(const bf16x8*)(wp + (size_t)nt * 16 * 2048 + ks * 32); wl[nt] = *(const bf16x8*)(wp + (size_t)(48 + nt * 16) * 2048 + ks * 32); }
#pragma unroll
            for (int mt = 0; mt < 4; ++mt) {
                const u32x4 au = __builtin_bit_cast(u32x4, af[mt]);
#pragma unroll
                for (int i = 0; i < 4; ++i) { const float lo = bflo(au[i]), hi2 = bfhi(au[i]); ss[mt] += lo * lo + hi2 * hi2; }
#pragma unroll
                for (int nt = 0; nt < 3; ++nt) {
                    acc[mt][nt] = __builtin_amdgcn_mfma_f32_16x16x32_bf16(wh[nt], af[mt], acc[mt][nt], 0, 0, 0);
                    acc[mt][nt] = __builtin_amdgcn_mfma_f32_16x16x32_bf16(wl[nt], af[mt], acc[mt][nt], 0, 0, 0);
                }
            }
        }
#pragma unroll
        for (int mt = 0; mt < 4; ++mt) {
#pragma unroll
            for (int nt = 0; nt < 3; ++nt) *(LAS f32x4*)(red + (wave * 64 + 16 * mt + fr) * 52 + 16 * nt + 4 * fq) = acc[mt][nt];
            float s1 = ss[mt]; s1 += __shfl_xor(s1, 16); s1 += __shfl_xor(s1, 32);
            if (fq == 0) red[(wave * 64 + 16 * mt + fr) * 52 + 48] = s1;
        }
        __syncthreads();
        for (int i = tid; i < 64 * 49; i += NTHR) { const int tk = i / 49, e = i - tk * 49; float sum = 0.f;
#pragma unroll
            for (int w = 0; w < 8; ++w) sum += red[(w * 64 + tk) * 52 + e];
            fin[tk * 52 + e] = sum; }
        __syncthreads();
        if (tid < 64) {
            const LAS float* f = fin + tid * 52; const int tok = t0 + tid;
            const float sr = rsqrtf(f[48] * (1.f / D) + EPS);
            float gl[4];
#pragma unroll
            for (int j = 0; j < 4; ++j) gl[j] = sr * f[j] + gb[j];
            int gi = 0; float gm = gl[0];
#pragma unroll
            for (int j = 1; j < 4; ++j) if (gl[j] > gm) { gm = gl[j]; gi = j; }
            float gs = 0.f;
#pragma unroll
            for (int j = 0; j < 4; ++j) gs += __expf(gl[j] - gm);
            const float gprob = 1.f / gs;
            int i0 = 0, i1 = 0; float v0 = -3.0e38f, v1 = -3.0e38f;
            for (int j = 0; j < 8; ++j) { const float v = sr * f[4 + 8 * gi + j] + eb[8 * gi + j];
                if (v > v0) { v1 = v0; i1 = i0; v0 = v; i0 = j; } else if (v > v1) { v1 = v; i1 = j; } }
            const float ex = __expf(v1 - v0); const float w0 = gprob / (1.f + ex), w1 = gprob * ex / (1.f + ex);
            const int e0 = 8 * gi + i0, e1 = 8 * gi + i1;
            u32x4 rec; rec.x = (unsigned)(e0 | (e1 << 8)); rec.y = __float_as_uint(w0); rec.z = __float_as_uint(w1); rec.w = __float_as_uint(sr);
            *((u32x4*)(ws + WS_TOKREC) + tok) = rec;
        }
        __syncthreads();
    }
}

__device__ __forceinline__ void build_lists(unsigned char* ws, unsigned* cnt, LAS unsigned char* lds, int vcu, int G) {
    const int tid = threadIdx.x, lane = tid & 63, wave = __builtin_amdgcn_readfirstlane(tid >> 6);
    const u32x4* rec = (const u32x4*)(ws + WS_TOKREC);
    int* rinfo = (int*)(ws + WS_RINFO); float* rw = (float*)(ws + WS_RW); float* rr = (float*)(ws + WS_RR);
    LAS int* sc = (LAS int*)lds;
    for (int e = vcu; e < 32; e += G) {
        unsigned m0 = 0u, m1 = 0u;
        for (int j = 0; j < 32; ++j) { const unsigned dec = rec[32 * tid + j].x; m0 |= ((dec & 255u) == (unsigned)e ? 1u : 0u) << j; m1 |= (((dec >> 8) & 255u) == (unsigned)e ? 1u : 0u) << j; }
        const int c = __popc(m0 | m1);
        int incl = c;
#pragma unroll
        for (int o = 1; o < 64; o <<= 1) { const int v = __shfl_up(incl, o); if (lane >= o) incl += v; }
        __syncthreads();
        if (lane == 63) sc[wave] = incl;
        __syncthreads();
        int wbase = 0, total = 0;
        for (int w = 0; w < 8; ++w) { const int v = sc[w]; total += v; if (w < wave) wbase += v; }
        size_t pos = (size_t)e * T + (size_t)(wbase + incl - c);
        unsigned mm = m0 | m1;
        while (mm) { const int j = __ffs(mm) - 1; mm &= mm - 1u; const int t = 32 * tid + j; const unsigned sl = (m1 >> j) & 1u; const u32x4 r = rec[t];
            rinfo[pos] = (t << 1) | (int)sl; rw[pos] = __uint_as_float(sl ? r.z : r.y); rr[pos] = __uint_as_float(r.w); ++pos; }
        if (tid == 0) cnt[e * 32] = (unsigned)total;
    }
}
__device__ __forceinline__ void moe_prefix(unsigned* cnt, LAS int* pre) {
    __syncthreads();
    if (threadIdx.x < 32) pre[40 + threadIdx.x] = (int)__hip_atomic_load(cnt + threadIdx.x * 32, __ATOMIC_RELAXED, __HIP_MEMORY_SCOPE_AGENT);
    __syncthreads();
    if (threadIdx.x == 0) { int s = 0; for (int e = 0; e < 32; ++e) { pre[e] = s; s += (pre[40 + e] + 255) >> 8; } pre[32] = s; }
    __syncthreads();
}

__device__ __forceinline__ void combine_phase(const bf16* hin, const bf16* slot, bf16* hout, float* rs, int vcu, int G) {
    const int tid = threadIdx.x, lane = tid & 63, wave = __builtin_amdgcn_readfirstlane(tid >> 6);
    const int gw = vcu * NWAVES + wave, NGW = G * NWAVES;
    for (int row = gw; row < T; row += NGW) {
        float ss = 0.f;
#pragma unroll
        for (int j = 0; j < 4; ++j) { const size_t off = (size_t)row * D + j * 512 + lane * 8;
            const u32x4 h = *(const u32x4*)(hin + off), s0 = *(const u32x4*)(slot + off), s1 = *(const u32x4*)(slot + (size_t)T * D + off); u32x4 w;
#pragma unroll
            for (int i = 0; i < 4; ++i) { const float lo = bflo(h[i]) + bflo(s0[i]) + bflo(s1[i]), hi2 = bfhi(h[i]) + bfhi(s0[i]) + bfhi(s1[i]); ss += lo * lo + hi2 * hi2; w[i] = cvtpk(lo, hi2); }
            *(u32x4*)(hout + off) = w; }
        ss = wave_sum(ss);
        if (lane == 0) rs[row] = rsqrtf(ss * (1.f / D) + EPS);
    }
}
__device__ __forceinline__ void final_phase(const bf16* hin, const float* g, float* out, int vcu, int G) {
    const int tid = threadIdx.x, lane = tid & 63, wave = __builtin_amdgcn_readfirstlane(tid >> 6);
    const int gw = vcu * NWAVES + wave, NGW = G * NWAVES;
    for (int row = gw; row < T; row += NGW) {
        float ss = 0.f; u32x4 h[4];
#pragma unroll
        for (int j = 0; j < 4; ++j) { h[j] = *(const u32x4*)(hin + (size_t)row * D + j * 512 + lane * 8);
#pragma unroll
            for (int i = 0; i < 4; ++i) { const float lo = bflo(h[j][i]), hi2 = bfhi(h[j][i]); ss += lo * lo + hi2 * hi2; } }
        const float r = rsqrtf(wave_sum(ss) * (1.f / D) + EPS);
#pragma unroll
        for (int j = 0; j < 4; ++j) { const f32x4 g0 = *(const f32x4*)(g + j * 512 + lane * 8), g1 = *(const f32x4*)(g + j * 512 + lane * 8 + 4); f32x4 o0, o1;
            o0[0] = bflo(h[j][0]) * r * g0[0]; o0[1] = bfhi(h[j][0]) * r * g0[1]; o0[2] = bflo(h[j][1]) * r * g0[2]; o0[3] = bfhi(h[j][1]) * r * g0[3];
            o1[0] = bflo(h[j][2]) * r * g1[0]; o1[1] = bfhi(h[j][2]) * r * g1[1]; o1[2] = bflo(h[j][3]) * r * g1[2]; o1[3] = bfhi(h[j][3]) * r * g1[3];
            __builtin_nontemporal_store(o0, (f32x4*)(out + (size_t)row * D + j * 512 + lane * 8)); __builtin_nontemporal_store(o1, (f32x4*)(out + (size_t)row * D + j * 512 + lane * 8 + 4)); }
    }
}

__device__ __forceinline__ int kvoff(int row, int ch) { return 256 * row + 16 * (ch ^ (((row & 3) << 2) | ((row >> 2) & 3))); }
__device__ __forceinline__ void attn_unit_params(int ui, int& pat, int& b, int& kvh, int& dsh, int& r, int& n) {
    const int x = ui & 15; kvh = (ui >> 4) & 7; b = (ui >> 7) & 7; pat = ui >> 10;
    dsh = 2 * pat; const int nsh = 4 - dsh;
    r = x >> nsh; n = x & ((1 << nsh) - 1);
}
__device__ __forceinline__ void attn_kv_load(const bf16* Kb, const bf16* Vb, int ui, int tid, u32x4 (&kr)[8], u32x4 (&vr)[8]) {
    int pat, b, kvh, dsh, r, n; attn_unit_params(ui, pat, b, kvh, dsh, r, n);
    const size_t rowbase = (size_t)b * SEQ;
#pragma unroll
    for (int pass = 0; pass < 8; ++pass) {
        const int row = pass * 32 + (tid >> 4), ch = tid & 15, spos = 128 * (n - 1) + row;
        if (spos >= 0) { const size_t tok = rowbase + ((size_t)spos << dsh) + r;
            kr[pass] = *(const u32x4*)(Kb + tok * 1024 + kvh * 128 + ch * 8); vr[pass] = *(const u32x4*)(Vb + tok * 1024 + kvh * 128 + ch * 8); }
    }
}
__device__ __forceinline__ void attn_phase(const Args& a, LAS unsigned char* lds, int vcu, int G) {
    const int tid = threadIdx.x, lane = tid & 63, wave = __builtin_amdgcn_readfirstlane(tid >> 6), hi = lane >> 5, ql = lane & 31;
    unsigned char* ws = a.ws;
    const bf16* Kb = (const bf16*)(ws + WS_KB); const bf16* Vb = (const bf16*)(ws + WS_VB); bf16* Q = (bf16*)(ws + WS_Q); float* lse = (float*)(ws + WS_LSE);
    LAS unsigned char* Ks = lds; LAS unsigned char* Vs = lds + 65536;
    const int i0w = 32 * (wave & 3);
    const int g4 = lane >> 4, li = lane & 15, tq = li >> 2, tp = li & 3;
    int kA[8], vA[2][4];
#pragma unroll
    for (int kk = 0; kk < 8; ++kk) kA[kk] = kvoff(i0w + ql, 2 * kk + hi);
#pragma unroll
    for (int h2 = 0; h2 < 2; ++h2)
#pragma unroll
        for (int dt = 0; dt < 4; ++dt) vA[h2][dt] = 65536 + kvoff(i0w + 4 * hi + tq + 8 * h2, 4 * dt + 2 * (g4 & 1) + (tp >> 1)) + 8 * (tp & 1);
    u32x4 kr[8], vr[8];
    if (vcu < 3072) attn_kv_load(Kb, Vb, vcu, tid, kr, vr);
    for (int ui = vcu; ui < 3072; ui += G) {
        int pat, b, kvh, dsh, r, n; attn_unit_params(ui, pat, b, kvh, dsh, r, n);
        const size_t rowbase = (size_t)b * SEQ;
        const int head = 2 * kvh + (wave >> 2), i0 = 32 * (wave & 3);
        const int sq = 128 * n + i0 + ql; const size_t tokq = rowbase + ((size_t)sq << dsh) + r;
        bf16* qrow = Q + tokq * 6144 + (size_t)(pat * 16 + head) * 128;
        bf16x8 qf[8];
#pragma unroll
        for (int kk = 0; kk < 8; ++kk) qf[kk] = *(const bf16x8*)(qrow + 16 * kk + 8 * hi);
#pragma unroll
        for (int pass = 0; pass < 8; ++pass) {
            const int row = pass * 32 + (tid >> 4), ch = tid & 15, spos = 128 * (n - 1) + row;
            if (spos >= 0) { *(LAS u32x4*)(Ks + kvoff(row, ch)) = kr[pass]; *(LAS u32x4*)(Vs + kvoff(row, ch)) = vr[pass]; }
        }
        __syncthreads();
        f32x16 S[5];
#pragma unroll
        for (int j = 0; j < 5; ++j) {
            const int kr0 = i0 + 32 * j; const bool valid = (n > 0) || (kr0 >= 128);
            f32x16 sacc;
#pragma unroll
            for (int i = 0; i < 16; ++i) sacc[i] = 0.f;
            if (valid) {
#pragma unroll
                for (int kk = 0; kk < 8; ++kk) { const bf16x8 kf = *(const LAS bf16x8*)(lds + kA[kk] + 8192 * j); sacc = __builtin_amdgcn_mfma_f32_32x32x16_bf16(kf, qf[kk], sacc, 0, 0, 0); }
            }
#pragma unroll
            for (int i = 0; i < 16; ++i) { const int c = (i & 3) + 8 * (i >> 2) + 4 * hi; bool ok = valid; if (j == 0) ok = ok && (c >= ql); if (j == 4) ok = ok && (c <= ql); sacc[i] = ok ? sacc[i] : -1e30f; }
            S[j] = sacc;
        }
        float mx = -1e30f;
#pragma unroll
        for (int j = 0; j < 5; ++j)
#pragma unroll
            for (int i = 0; i < 16; ++i) mx = fmaxf(mx, S[j][i]);
        mx = fmaxf(mx, __shfl_xor(mx, 32));
        float den = 0.f;
#pragma unroll
        for (int j = 0; j < 5; ++j)
#pragma unroll
            for (int i = 0; i < 16; ++i) { const float e = __builtin_amdgcn_exp2f((S[j][i] - mx) * 1.4426950408889634f); S[j][i] = e; den += e; }
        den += __shfl_xor(den, 32);
        bf16x8 pfr[5][2];
#pragma unroll
        for (int j = 0; j < 5; ++j)
#pragma unroll
            for (int s2 = 0; s2 < 2; ++s2) { u32x4 pw; pw.x = cvtpk(S[j][8 * s2 + 0], S[j][8 * s2 + 1]); pw.y = cvtpk(S[j][8 * s2 + 2], S[j][8 * s2 + 3]); pw.z = cvtpk(S[j][8 * s2 + 4], S[j][8 * s2 + 5]); pw.w = cvtpk(S[j][8 * s2 + 6], S[j][8 * s2 + 7]);
                pfr[j][s2] = __builtin_bit_cast(bf16x8, pw); }
        if (ui + G < 3072) attn_kv_load(Kb, Vb, ui + G, tid, kr, vr);
        f32x16 O[4];
#pragma unroll
        for (int dt = 0; dt < 4; ++dt)
#pragma unroll
            for (int i = 0; i < 16; ++i) O[dt][i] = 0.f;
#pragma unroll
        for (int j = 0; j < 5; ++j) {
            const int kr0 = i0 + 32 * j; const bool valid = (n > 0) || (kr0 >= 128);
            if (valid) {
#pragma unroll
                for (int s2 = 0; s2 < 2; ++s2) {
                    const bf16x8 pf = pfr[j][s2];
#pragma unroll
                    for (int dt = 0; dt < 4; ++dt) {
                        const s16x4 v0 = __builtin_amdgcn_ds_read_tr16_b64_v4i16((LAS s16x4*)(lds + vA[0][dt] + 8192 * j + 4096 * s2));
                        const s16x4 v1 = __builtin_amdgcn_ds_read_tr16_b64_v4i16((LAS s16x4*)(lds + vA[1][dt] + 8192 * j + 4096 * s2));
                        bf16x8 vf; vf[0] = v0[0]; vf[1] = v0[1]; vf[2] = v0[2]; vf[3] = v0[3]; vf[4] = v1[0]; vf[5] = v1[1]; vf[6] = v1[2]; vf[7] = v1[3];
                        O[dt] = __builtin_amdgcn_mfma_f32_32x32x16_bf16(vf, pf, O[dt], 0, 0, 0);
                    }
                }
            }
        }
        const float inv = __builtin_amdgcn_rcpf(den);
#pragma unroll
        for (int dt = 0; dt < 4; ++dt)
#pragma unroll
            for (int qp = 0; qp < 2; ++qp) {
                u32x2 we, wo;
                we.x = cvtpk(O[dt][8 * qp] * inv, O[dt][8 * qp + 1] * inv); we.y = cvtpk(O[dt][8 * qp + 2] * inv, O[dt][8 * qp + 3] * inv);
                wo.x = cvtpk(O[dt][8 * qp + 4] * inv, O[dt][8 * qp + 5] * inv); wo.y = cvtpk(O[dt][8 * qp + 6] * inv, O[dt][8 * qp + 7] * inv);
                const u32x2 give = hi ? we : wo;
                u32x2 got; got.x = (unsigned)__shfl_xor((int)give.x, 32); got.y = (unsigned)__shfl_xor((int)give.y, 32);
                u32x4 w16; if (hi) { w16.x = got.x; w16.y = got.y; w16.z = wo.x; w16.w = wo.y; } else { w16.x = we.x; w16.y = we.y; w16.z = got.x; w16.w = got.y; }
                *(u32x4*)(qrow + 32 * dt + 16 * qp + 8 * hi) = w16; }
        if (hi == 0) lse[((size_t)pat * T + tokq) * 16 + head] = mx + __logf(den);
        __syncthreads();
    }
}
__device__ __forceinline__ void merge_phase(const Args& a, int vcu, int G) {
    const int tid = threadIdx.x, lane = tid & 63, wave = __builtin_amdgcn_readfirstlane(tid >> 6);
    const int gw = vcu * NWAVES + wave, NGW = G * NWAVES;
    unsigned char* ws = a.ws; const bf16* Q = (const bf16*)(ws + WS_Q); const float* lse = (const float*)(ws + WS_LSE); bf16* O = (bf16*)(ws + WS_O);
    for (int row = gw; row < T; row += NGW) {
#pragma unroll
        for (int j = 0; j < 4; ++j) { const int head = 4 * j + (lane >> 4), d0 = (lane & 15) * 8;
            const float l0 = lse[((size_t)0 * T + row) * 16 + head], l1 = lse[((size_t)1 * T + row) * 16 + head], l2 = lse[((size_t)2 * T + row) * 16 + head];
            const float mx = fmaxf(l0, fmaxf(l1, l2)); float w0 = __expf(l0 - mx), w1 = __expf(l1 - mx), w2 = __expf(l2 - mx); const float inv = 1.f / (w0 + w1 + w2); w0 *= inv; w1 *= inv; w2 *= inv;
            const u32x4 o0 = *(const u32x4*)(Q + (size_t)row * 6144 + (0 * 16 + head) * 128 + d0), o1 = *(const u32x4*)(Q + (size_t)row * 6144 + (1 * 16 + head) * 128 + d0), o2 = *(const u32x4*)(Q + (size_t)row * 6144 + (2 * 16 + head) * 128 + d0);
            u32x4 w;
#pragma unroll
            for (int i = 0; i < 4; ++i) w[i] = cvtpk(w0 * bflo(o0[i]) + w1 * bflo(o1[i]) + w2 * bflo(o2[i]), w0 * bfhi(o0[i]) + w1 * bfhi(o1[i]) + w2 * bfhi(o2[i]));
            *(u32x4*)(O + (size_t)row * D + head * 128 + d0) = w; }
    }
}

#define GEMM_RUN(K, S, E) pg8::gemm_phase<false, true>(lds, K, S, E)
#define GEMM_RUN_G(K, S, E) pg8::gemm_phase<true, true>(lds, K, S, E)
#define GEMM_RUN_2ND(K, S, E) pg8::gemm_phase<false, true, true>(lds, K, S, E)
__global__ void __launch_bounds__(NTHR, 2) fwd(Args a) {
    extern __shared__ __attribute__((aligned(16))) unsigned char lds_raw[];
    LAS unsigned char* lds = (LAS unsigned char*)lds_raw;
    const int tid = threadIdx.x;
    const int G = gridDim.x; const int bx = blockIdx.x; const int vcu = (G % 8 == 0) ? (bx % 8) * (G / 8) + bx / 8 : bx;
    unsigned char* ws = a.ws;
    unsigned* ctl = (unsigned*)(ws + WS_CTL);
    volatile LAS unsigned* MISC = (volatile LAS unsigned*)(lds + 146 * 1024);
    LAS int* pre = (LAS int*)(lds + 147 * 1024);
    if (tid < 64) MISC[tid] = 0u;
    __syncthreads();
    const int lo = a.ph_lo, hi = a.ph_hi;
    XcdBarrier bar; bar.bar = ctl + CW_BAR; bar.x = 0; bar.st = nullptr;
    if (hi - lo > 1) bar = xcd_barrier_post(ctl + CW_BAR, MISC + 8);
#ifndef PHM
#define PHM 0xfffff
#endif
#define IN(k) (((PHM >> (k)) & 1) && lo <= (k) && (k) < hi)
#define SEAM(k) do { if (IN(k) && IN((k) + 1)) xcd_barrier(bar); } while (0)
#define HA ((bf16*)(a.ws + WS_HA))
#define HB ((bf16*)(a.ws + WS_HB))
#define RS ((float*)(a.ws + WS_RSTAT))
#define rinfo ((const int*)(a.ws + WS_RINFO))

    if (IN(0)) { p0_prologue(a, lds, vcu, G); } SEAM(0);
    if (IN(1)) {
        s5_phase(a, lds, vcu, G);
    } SEAM(1);
    if (IN(2)) {
        DenseSched S{(const bf16*)(ws + WS_G0), (const bf16*)(ws + WS_WGLU), 2048, 64, 16, G, bx};
        EpiGLU E{a.in[0], a.in[12], HA};
        GEMM_RUN(2048, S, E);
    } SEAM(2);
    if (IN(3)) { router_phase(a, 0, HA, lds, vcu, G); } SEAM(3);
    if (IN(4)) { build_lists(ws, ctl + CW_CNT, lds, vcu, G); } SEAM(4);
    if (IN(5)) {
        moe_prefix(ctl + CW_CNT, pre);
        MoeSched S{HA, (const bf16*)(ws + WS_WGU), rinfo, pre, 2048, 4, G, bx, (size_t)1024 * 2048, true};
        EpiGateUp E{(const float*)(ws + WS_RR), (const float*)(ws + WS_RW), (bf16*)(ws + WS_HID), rinfo};
        GEMM_RUN_G(2048, S, E);
        {
            const int tot = pre[32] * 4; const int R = (tot % G == 0) ? 0 : tot % G;
            FillSched SF{(const bf16*)(ws + WS_PBF), (const bf16*)(ws + WS_WPP), 256, 64, 8, G, bx, R};
            EpiStore EF{(bf16*)(ws + WS_PP), D};
            GEMM_RUN_2ND(256, SF, EF); }
    } SEAM(5);
    if (IN(6)) {
        moe_prefix(ctl + CW_CNT, pre);
        MoeSched S{(const bf16*)(ws + WS_HID), (const bf16*)(ws + WS_WDN), rinfo, pre, 512, 8, G, bx, (size_t)2048 * 512, false};
        EpiDown E{(bf16*)(ws + WS_SLOT)};
        GEMM_RUN(512, S, E);
    } SEAM(6);
    if (IN(7)) { combine_phase(HA, (const bf16*)(ws + WS_SLOT), HB, RS, vcu, G); } SEAM(7);
    if (IN(8)) {
        DenseSched S{HB, (const bf16*)(ws + WS_WPG), 2048, 64, 8, G, bx};
        EpiPLE E{HB, (const bf16*)(ws + WS_PP), RS, HA, (float*)(ws + WS_PART)};
        GEMM_RUN(2048, S, E);
    } SEAM(8);
    if (IN(9)) {
        DenseSched S{HA, (const bf16*)(ws + WS_WQKV), 2048, 64, 32, G, bx};
        EpiQKV E{(const float*)(ws + WS_PART), (const float*)(ws + WS_ROPE), (bf16*)(ws + WS_Q), (bf16*)(ws + WS_KB), (bf16*)(ws + WS_VB)};
        GEMM_RUN(2048, S, E);
    } SEAM(9);
    if (IN(10)) { attn_phase(a, lds, vcu, G); } SEAM(10);
    if (IN(11)) { merge_phase(a, vcu, G); } SEAM(11);
    if (IN(12)) {
        DenseSched S{(const bf16*)(ws + WS_O), (const bf16*)(ws + WS_WO), 2048, 64, 8, G, bx};
        EpiResAdd E{HA, HB};
        GEMM_RUN(2048, S, E);
    } SEAM(12);
    if (IN(13)) {
        router_phase(a, 1, HB, lds, vcu, G);
        const int lane = tid & 63, wave = __builtin_amdgcn_readfirstlane(tid >> 6);
        moe_weights(a, 1, vcu * NWAVES + wave, G * NWAVES, lds + wave * 16384, lane);
    } SEAM(13);
    if (IN(14)) { build_lists(ws, ctl + CW_CNT + 1024, lds, vcu, G); } SEAM(14);
    if (IN(15)) {
        moe_prefix(ctl + CW_CNT + 1024, pre);
        MoeSched S{HB, (const bf16*)(ws + WS_WGU), rinfo, pre, 2048, 4, G, bx, (size_t)1024 * 2048, true};
        EpiGateUp E{(const float*)(ws + WS_RR), (const float*)(ws + WS_RW), (bf16*)(ws + WS_HID), rinfo};
        GEMM_RUN_G(2048, S, E);
        {
            const int tot = pre[32] * 4; const int R = (tot % G == 0) ? 0 : tot % G;
            FillSched SF{(const bf16*)(ws + WS_PBF) + (size_t)T * 256, (const bf16*)(ws + WS_WPP) + (size_t)2048 * 256, 256, 64, 8, G, bx, R};
            EpiStore EF{(bf16*)(ws + WS_PP) + (size_t)T * D, D};
            GEMM_RUN_2ND(256, SF, EF); }
    } SEAM(15);
    if (IN(16)) {
        moe_prefix(ctl + CW_CNT + 1024, pre);
        MoeSched S{(const bf16*)(ws + WS_HID), (const bf16*)(ws + WS_WDN), rinfo, pre, 512, 8, G, bx, (size_t)2048 * 512, false};
        EpiDown E{(bf16*)(ws + WS_SLOT)};
        GEMM_RUN(512, S, E);
    } SEAM(16);
    if (IN(17)) { combine_phase(HB, (const bf16*)(ws + WS_SLOT), HA, RS, vcu, G); } SEAM(17);
    if (IN(18)) {
        DenseSched S{HA, (const bf16*)(ws + WS_WPG) + (size_t)2048 * 2048, 2048, 64, 8, G, bx};
        EpiPLE E{HA, (const bf16*)(ws + WS_PP) + (size_t)T * D, RS, HB, (float*)(ws + WS_PART)};
        GEMM_RUN(2048, S, E);
    } SEAM(18);
    if (IN(19)) { final_phase(HB, a.in[30], a.out, vcu, G); }
#undef IN
#undef SEAM
#undef HA
#undef HB
#undef RS
#undef rinfo
}

extern "C" void kernel_launch(void* const* d_in, const int* in_sizes, int n_in, void* d_out, int out_size, void* d_ws, size_t ws_size, hipStream_t stream) {
    static int grid = 0;
    if (grid == 0) {
        if (n_in != 31 || out_size != T * D || ws_size < WS_END) { fprintf(stderr, "kernel_launch: unexpected shapes (n_in %d, out %d, ws %zu)\n", n_in, out_size, ws_size); grid = -1; return; }
        int dev = 0, cus = 0, per_cu = 0;
        if (hipGetDevice(&dev) != hipSuccess || hipDeviceGetAttribute(&cus, hipDeviceAttributeMultiprocessorCount, dev) != hipSuccess) { grid = -1; return; }
        if (hipFuncSetAttribute((const void*)fwd, hipFuncAttributeMaxDynamicSharedMemorySize, LDS_BYTES) != hipSuccess) { fprintf(stderr, "kernel_launch: hipFuncSetAttribute failed\n"); grid = -1; return; }
        if (hipOccupancyMaxActiveBlocksPerMultiprocessor(&per_cu, (const void*)fwd, NTHR, LDS_BYTES) != hipSuccess || per_cu < 1) fprintf(stderr, "kernel_launch: occupancy query reports %d\n", per_cu);
        (void)hipGetLastError();
        grid = cus;
    }
    if (grid < 0) return;
    if (hipMemsetAsync((char*)d_ws + WS_CTL, 0, CTL_ZERO_BYTES, stream) != hipSuccess) return;
    Args a{};
    for (int i = 0; i < 31; ++i) a.in[i] = (const float*)d_in[i];
    a.out = (float*)d_out; a.ws = (unsigned char*)d_ws;
#if MK_N_LAUNCHES == 1
    a.ph_lo = 0; a.ph_hi = NPH;
    hipLaunchKernelGGL(fwd, dim3(grid), dim3(NTHR), LDS_BYTES, stream, a);
#else
    for (int p = 0; p < NPH; ++p) { a.ph_lo = p; a.ph_hi = p + 1; hipLaunchKernelGGL(fwd, dim3(grid), dim3(NTHR), LDS_BYTES, stream, a); }
#endif
}
```

```cpp
#include <hip/hip_runtime.h>
#include <cstdio>
#include <cstdint>

#define GAS __attribute__((address_space(1)))
#define LAS __attribute__((address_space(3)))
typedef unsigned short bf16;
typedef short bf16x8 __attribute__((ext_vector_type(8)));
typedef short s16x4 __attribute__((ext_vector_type(4)));
typedef float f32x2 __attribute__((ext_vector_type(2)));
typedef float f32x4 __attribute__((ext_vector_type(4)));
typedef float f32x16 __attribute__((ext_vector_type(16)));
typedef unsigned u32x2 __attribute__((ext_vector_type(2)));
typedef unsigned u32x4 __attribute__((ext_vector_type(4)));
typedef __bf16 bf16x2_t __attribute__((ext_vector_type(2)));

#ifndef MK_N_LAUNCHES
#define MK_N_LAUNCHES 1
#endif

constexpr int T = 16384, D = 2048, SEQ = 2048;
constexpr int NWAVES = 8, NTHR = 512;
constexpr int NPH = 20;
constexpr float EPS = 1e-6f;
constexpr int LDS_BYTES = 159744;

constexpr size_t MiB = 1u << 20;
constexpr size_t WS_CTL = 0, CTL_ZERO_BYTES = 1 * MiB;
constexpr size_t WS_ROPE = 1 * MiB;
constexpr size_t WS_S5B = 2 * MiB;
constexpr size_t WS_S5D = 2 * MiB + 512 * 1024;
constexpr size_t WS_LB = 2 * MiB + 768 * 1024;
constexpr size_t WS_S5C = 3 * MiB;
constexpr size_t WS_WR = 4 * MiB;
constexpr size_t WS_RSTAT = 5 * MiB;
constexpr size_t WS_PART = 6 * MiB;
constexpr size_t WS_LSE = 8 * MiB;
constexpr size_t WS_RINFO = 12 * MiB;
constexpr size_t WS_RW = 14 * MiB;
constexpr size_t WS_RR = 16 * MiB;
constexpr size_t WS_TOKREC = 18 * MiB;
constexpr size_t WS_PBF = 20 * MiB;
constexpr size_t WS_WGLU = 40 * MiB;
constexpr size_t WS_WQKV = 56 * MiB;
constexpr size_t WS_WO = 88 * MiB;
constexpr size_t WS_WPG = 96 * MiB;
constexpr size_t WS_WPP = 112 * MiB;
constexpr size_t WS_WGU = 116 * MiB;
constexpr size_t WS_WDN = 244 * MiB;
constexpr size_t WS_X = 308 * MiB;
constexpr size_t WS_U0 = WS_X, WS_G0 = WS_X + 64 * MiB;
constexpr size_t WS_SLOT = WS_X, WS_HID = WS_X + 128 * MiB;
constexpr size_t WS_Q = WS_X, WS_O = WS_X + 192 * MiB;
constexpr size_t WS_KB = 564 * MiB, WS_VB = 596 * MiB;
constexpr size_t WS_PP = 628 * MiB;
constexpr size_t WS_HA = 756 * MiB, WS_HB = 820 * MiB;
constexpr size_t WS_END = 884 * MiB;
constexpr int CW_BAR = 4096;
constexpr int CW_RDONE = 24576;
constexpr int CW_CNT = 16384;

__device__ __forceinline__ unsigned cvtpk(float lo, float hi) { f32x2 v = {lo, hi}; bf16x2_t b = __builtin_convertvector(v, bf16x2_t); return __builtin_bit_cast(unsigned, b); }
__device__ __forceinline__ float bflo(unsigned w) { return __uint_as_float(w << 16); }
__device__ __forceinline__ float bfhi(unsigned w) { return __uint_as_float(w & 0xffff0000u); }
__device__ __forceinline__ float wave_sum(float v) {
#pragma unroll
    for (int o = 1; o < 64; o <<= 1) v += __shfl_xor(v, o);
    return v;
}
__device__ __forceinline__ float sigmoidf_(float x) { return __builtin_amdgcn_rcpf(1.f + __builtin_amdgcn_exp2f(-1.4426950408889634f * x)); }
__device__ __forceinline__ float gelu_tanh(float x) { const float z = x * (2.3022082f + 0.1029432f * x * x); return x * __builtin_amdgcn_rcpf(1.f + __builtin_amdgcn_exp2f(-z)); }
#define LDS_WAIT() asm volatile("s_waitcnt lgkmcnt(0)" ::: "memory")

#define XB_TMO      128
#define XB_XCNT(j)  (256  + 64 * (j))
#define XB_XSUB(j)  (1280 + 64 * (j))
#define XB_XGEN(j)  (2304 + 64 * (j))
#define XB_TOP      3328
#define XB_TOPGEN   3392
#define XCD_BAR_WORDS 3456
#define XB_SPIN_CAP (1u << 18)
__device__ __forceinline__ unsigned xb_ld(unsigned* p)              { return __hip_atomic_load(p, __ATOMIC_RELAXED, __HIP_MEMORY_SCOPE_AGENT); }
__device__ __forceinline__ unsigned xb_add(unsigned* p, unsigned v) { return __hip_atomic_fetch_add(p, v, __ATOMIC_RELAXED, __HIP_MEMORY_SCOPE_AGENT); }
__device__ __forceinline__ unsigned xb_xcc_id() { return (unsigned)__builtin_amdgcn_s_getreg((3 << 11) | 20) & 0xFu; }
#define XB_SPIN(cond, bar) do { unsigned _sp = 0; while (cond) { __builtin_amdgcn_s_sleep(1); \
    if ((++_sp & 255u) == 0u) { if (xb_ld(&(bar)[XB_TMO])) break; if (_sp > XB_SPIN_CAP) { atomicAdd(&(bar)[XB_TMO], 1u); break; } } } } while (0)
struct XcdBarrier { unsigned* bar; unsigned x; volatile LAS unsigned* st; };
__device__ __forceinline__ XcdBarrier xcd_barrier_post(unsigned* bar, volatile LAS unsigned* st) {
    XcdBarrier b; b.bar = bar; b.x = xb_xcc_id(); b.st = st;
    if (threadIdx.x == 0) (void)xb_add(&bar[XB_XCNT(b.x)], 1u);
    return b;
}
__device__ __forceinline__ void xcd_barrier_complete(unsigned* bar, unsigned x, unsigned& nloc, unsigned& nx) {
    const unsigned G = gridDim.x * gridDim.y * gridDim.z;
    unsigned sum, cnt, mine, sp = 0u;
    for (;;) {
        sum = 0u; cnt = 0u; mine = 0u;
#pragma unroll
        for (unsigned j = 0; j < 16; ++j) { const unsigned c = xb_ld(&bar[XB_XCNT(j)]); sum += c; cnt += (c > 0u) ? 1u : 0u; mine = (j == x) ? c : mine; }
        if (sum == G) break;
        __builtin_amdgcn_s_sleep(1);
        if ((++sp & 255u) == 0u) { if (xb_ld(&bar[XB_TMO])) break; if (sp > XB_SPIN_CAP) { atomicAdd(&bar[XB_TMO], 1u); break; } }
    }
    nloc = mine > 0u ? mine : 1u; nx = cnt > 0u ? cnt : 1u;
}
__device__ __forceinline__ void xcd_barrier(const XcdBarrier& b) {
    asm volatile("s_waitcnt vmcnt(0)" ::: "memory");
    __syncthreads();
    if (threadIdx.x == 0) {
        unsigned* bar = b.bar;
        __builtin_amdgcn_s_waitcnt(0);
        unsigned nloc = b.st[0], nx = b.st[1];
        if (nloc == 0u) { xcd_barrier_complete(bar, b.x, nloc, nx); b.st[0] = nloc; b.st[1] = nx; }
        const unsigned old = xb_add(&bar[XB_XSUB(b.x)], 1u);
        const unsigned gen = old / nloc;
        if (old + 1u == (gen + 1u) * nloc) {
            __builtin_amdgcn_fence(__ATOMIC_RELEASE, "agent");
            asm volatile("s_waitcnt vmcnt(0)" ::: "memory");
            const unsigned og = xb_add(&bar[XB_TOP], 1u);
            const unsigned tg = og / nx;
            if (og + 1u == (tg + 1u) * nx) xb_add(&bar[XB_TOPGEN], 1u);
            else XB_SPIN(xb_ld(&bar[XB_TOPGEN]) == tg, bar);
            __builtin_amdgcn_fence(__ATOMIC_ACQUIRE, "agent");
            xb_add(&bar[XB_XGEN(b.x)], 1u);
            asm volatile("s_waitcnt vmcnt(0)" ::: "memory");
        } else {
            XB_SPIN(xb_ld(&bar[XB_XGEN(b.x)]) == gen, bar);
            __builtin_amdgcn_fence(__ATOMIC_ACQUIRE, "agent");
            asm volatile("s_waitcnt vmcnt(0)" ::: "memory");
        }
    }
    __syncthreads();
}

struct WUnit { const bf16* A; const bf16* B; const int* gidx; const int* info; int pm, pn, ex, nrows; };

namespace pg8 {
constexpr int BK = 64, HALF = 128, HTB = HALF * BK * 2, STAGE_BYTES = 8 * HTB;
__device__ __forceinline__ int lds_byte(int r, int c) { const int cc = c >> 3; return (r >> 3) * 1024 + ((((r & 7) << 3) | (cc ^ ((r >> 1) & 7))) << 4) + (c & 7) * 2; }
__device__ __forceinline__ void stage_rc(int b, int& R, int& C) { const int t = b >> 4, w = t >> 6, l = t & 63; R = 8 * w + (l >> 3); C = 8 * ((l & 7) ^ ((R >> 1) & 7)); }

template <bool GATHER>
__device__ __forceinline__ void unit_offsets(const WUnit& u, const int K, int R0, int C0, unsigned (&o)[2][2]) {
    if (GATHER) { int t = threadIdx.x; asm volatile("" : "+v"(t)); stage_rc(t * 16, R0, C0); }
#pragma unroll
    for (int h = 0; h < 2; ++h)
#pragma unroll
        for (int i = 0; i < 2; ++i) {
            int row = R0 + 64 * i + HALF * h;
            if (GATHER) row = (row < u.nrows) ? (u.gidx[row] >> 1) : 0;
            o[h][i] = ((unsigned)row * (unsigned)K + (unsigned)C0) * 2u;
        }
}

template <bool GATHER, bool ALIGN_EPI, bool FRESH_TID = false, class Epi, class Sched>
__device__ __forceinline__ void gemm_phase(LAS unsigned char* lds, const int K, const Sched& S, const Epi& E) {
    int tid_ = threadIdx.x; if (FRESH_TID) asm volatile("" : "+v"(tid_));
    const int tid = tid_, wid = __builtin_amdgcn_readfirstlane(tid >> 6), lane = tid & 63, wr = wid >> 2, wc = wid & 3, fr = lane & 15, fq = lane >> 4;
    const int nt = K / BK;
    int sR, sC; stage_rc(tid * 16, sR, sC);
    const int sRb = (sR & ~31) + (8 * ((sR & 15) >> 2) + 4 * ((sR >> 4) & 1) + (sR & 3));
    const unsigned voffB0 = (unsigned)(sRb * 64 + sC) * 2u; const unsigned r64 = 64u * (unsigned)K * 2u;
    const size_t kstep = (size_t)(BK * 2), kstepB = 8192;
    const size_t hstep = (size_t)HALF * K * 2;
    const unsigned ldsw = (unsigned)wid * 1024u;
    const int aoff0 = lds_byte(wr * 64 + fr, fq * 8), boff0 = lds_byte(wc * 32 + fr, fq * 8);
#define PG8_SA(b, h) (((b) * 2 + (h)) * HTB)
#define PG8_SB(b, h) ((4 + (b) * 2 + (h)) * HTB)
#define PG8_STAGE_B(bufoff, gbase) do { \
        __builtin_amdgcn_global_load_lds((const unsigned*)((const char*)(gbase) + voffB0), (LAS unsigned*)(lds + (bufoff) + ldsw), 16, 0, 0); \
        __builtin_amdgcn_global_load_lds((const unsigned*)((const char*)(gbase) + r64 + voffB0), (LAS unsigned*)(lds + (bufoff) + ldsw + 8192), 16, 0, 0); } while (0)
#define PG8_STAGE_A(bufoff, gbase, o0, o1) do { \
        __builtin_amdgcn_global_load_lds((const unsigned*)((const char*)(gbase) + (o0)), (LAS unsigned*)(lds + (bufoff) + ldsw), 16, 0, 0); \
        __builtin_amdgcn_global_load_lds((const unsigned*)((const char*)(gbase) + (o1)), (LAS unsigned*)(lds + (bufoff) + ldsw + 8192), 16, 0, 0); } while (0)
#define PG8_LDA(dst, b, h) do { int aoff1; asm volatile("v_xor_b32 %0, 64, %1" : "=v"(aoff1) : "v"(aoff0)); _Pragma("unroll") for (int m = 0; m < 4; ++m) _Pragma("unroll") for (int k = 0; k < 2; ++k) dst[m][k] = *(const LAS bf16x8*)(lds + PG8_SA(b, h) + (k ? aoff1 : aoff0) + m * 2048); } while (0)
#define PG8_LDB(dst, b, h) do { int boff1; asm volatile("v_xor_b32 %0, 64, %1" : "=v"(boff1) : "v"(boff0)); _Pragma("unroll") for (int n = 0; n < 2; ++n) _Pragma("unroll") for (int k = 0; k < 2; ++k) dst[n][k] = *(const LAS bf16x8*)(lds + PG8_SB(b, h) + (k ? boff1 : boff0) + n * 2048); } while (0)
#define PG8_MMA(ai, bj, At, Bt) do { __builtin_amdgcn_s_setprio(1); _Pragma("unroll") for (int m = 0; m < 4; ++m) _Pragma("unroll") for (int n = 0; n < 2; ++n) _Pragma("unroll") for (int k = 0; k < 2; ++k) \
        acc[ai][bj][m][n] = __builtin_amdgcn_mfma_f32_16x16x32_bf16(Bt[n][k], At[m][k], acc[ai][bj][m][n], 0, 0, 0); __builtin_amdgcn_s_setprio(0); } while (0)
#define PG8_WAIT_V(n) asm volatile("s_waitcnt vmcnt(" #n ")" ::: "memory")
#define PG8_WAIT_L(n) asm volatile("s_waitcnt lgkmcnt(" #n ")" ::: "memory")
#define PG8_BAR __builtin_amdgcn_s_barrier()
#define PG8_SCHED __builtin_amdgcn_sched_barrier(0)
    WUnit cur, nxt; int ui = 0;
    if (!S.next(0, cur)) return;
    unsigned oc[2][2];
    LAS unsigned char* pk = lds + STAGE_BYTES + tid * 32;
    unit_offsets<GATHER>(cur, K, sR, sC, oc);
    if constexpr (GATHER) { u32x4 q; q.x = oc[0][0]; q.y = oc[0][1]; q.z = oc[1][0]; q.w = oc[1][1]; *(LAS u32x4*)pk = q; }
    f32x4 acc[2][2][4][2];
#pragma unroll
    for (int a = 0; a < 2; ++a)
#pragma unroll
        for (int b = 0; b < 2; ++b)
#pragma unroll
            for (int m = 0; m < 4; ++m)
#pragma unroll
                for (int n = 0; n < 2; ++n) acc[a][b][m][n] = (f32x4){0.f, 0.f, 0.f, 0.f};
    bf16x8 At[4][2], B0[2][2], B1[2][2];
    const char* cA = (const char*)cur.A; const char* cB = (const char*)cur.B;
    PG8_STAGE_B(PG8_SB(0, 0), cB); PG8_STAGE_B(PG8_SB(0, 1), cB + hstep); PG8_STAGE_A(PG8_SA(0, 0), cA, oc[0][0], oc[0][1]); PG8_STAGE_A(PG8_SA(0, 1), cA, oc[1][0], oc[1][1]);
    if (wr == 1) PG8_BAR;
    PG8_WAIT_V(2); PG8_BAR;
    PG8_STAGE_B(PG8_SB(1, 0), cB + kstepB); PG8_STAGE_A(PG8_SA(1, 0), cA + kstep, oc[0][0], oc[0][1]); PG8_STAGE_B(PG8_SB(1, 1), cB + hstep + kstepB);
    PG8_WAIT_V(6); PG8_BAR;
    for (;;) {
        const bool has_next = S.next(ui + 1, nxt);
        const char* nA = has_next ? (const char*)nxt.A : cA; const char* nB = has_next ? (const char*)nxt.B : cB;
        if constexpr (GATHER) {
            unsigned on[2][2];
            if (has_next) unit_offsets<true>(nxt, K, sR, sC, on);
            else { const u32x4 q = *(const LAS u32x4*)pk; on[0][0] = q.x; on[0][1] = q.y; on[1][0] = q.z; on[1][1] = q.w; }
            u32x4 q; q.x = on[0][0]; q.y = on[0][1]; q.z = on[1][0]; q.w = on[1][1]; *(LAS u32x4*)(pk + 16) = q;
        }
#pragma clang loop unroll(disable)
        for (int t = 0; t < nt; t += 2) {
            const bool last = (t == nt - 2);
            const char* a1 = cA + (size_t)(t + 1) * kstep;
            const char* a2 = last ? nA : cA + (size_t)(t + 2) * kstep; const char* b2 = last ? nB : cB + (size_t)(t + 2) * kstepB;
            const char* a3 = a2 + kstep; const char* b3 = b2 + kstepB;
            const int nsel = (GATHER && last) ? 16 : 0;
#define PG8_OFF(h, base) (GATHER ? *(const LAS u32x2*)(pk + (base) + 8 * (h)) : (u32x2){oc[h][0], oc[h][1]})
            { const u32x2 o = PG8_OFF(1, 0);
              PG8_LDB(B0, 0, 0); PG8_LDB(B1, 0, 1); PG8_SCHED; PG8_LDA(At, 0, 0); PG8_STAGE_A(PG8_SA(1, 1), a1, o.x, o.y); }
            PG8_WAIT_V(8); PG8_WAIT_L(0); PG8_BAR; PG8_MMA(0, 0, At, B0); PG8_MMA(0, 1, At, B1); PG8_BAR; PG8_SCHED;
            { const u32x2 o = PG8_OFF(0, nsel);
              PG8_LDA(At, 0, 1); PG8_STAGE_B(PG8_SB(0, 0), b2); PG8_STAGE_B(PG8_SB(0, 1), b2 + hstep); PG8_STAGE_A(PG8_SA(0, 0), a2, o.x, o.y); }
            PG8_WAIT_V(8); PG8_WAIT_L(0); PG8_BAR; PG8_MMA(1, 0, At, B0); PG8_MMA(1, 1, At, B1); PG8_BAR; PG8_SCHED;
            { const u32x2 o = PG8_OFF(1, nsel);
              PG8_LDB(B0, 1, 0); PG8_LDB(B1, 1, 1); PG8_SCHED; PG8_LDA(At, 1, 0); PG8_STAGE_A(PG8_SA(0, 1), a2, o.x, o.y); }
            PG8_WAIT_V(8); PG8_WAIT_L(0); PG8_BAR; PG8_MMA(0, 0, At, B0); PG8_MMA(0, 1, At, B1); PG8_BAR; PG8_SCHED;
            { const u32x2 o = PG8_OFF(0, nsel);
              PG8_LDA(At, 1, 1); PG8_STAGE_B(PG8_SB(1, 0), b3); PG8_STAGE_B(PG8_SB(1, 1), b3 + hstep); PG8_STAGE_A(PG8_SA(1, 0), a3, o.x, o.y); }
            PG8_WAIT_V(8); PG8_WAIT_L(0); PG8_BAR; PG8_MMA(1, 0, At, B0); PG8_MMA(1, 1, At, B1); PG8_BAR; PG8_SCHED;
#undef PG8_OFF
        }
        if constexpr (ALIGN_EPI) { if (wr == 0) PG8_BAR; }
        { int fr_ = fr, fq_ = fq; asm volatile("" : "+v"(fr_), "+v"(fq_));
          E(acc, cur, wr, wc, fr_, fq_); }
        if (!has_next) break;
#pragma unroll
        for (int a = 0; a < 2; ++a)
#pragma unroll
            for (int b = 0; b < 2; ++b)
#pragma unroll
                for (int m = 0; m < 4; ++m)
#pragma unroll
                    for (int n = 0; n < 2; ++n) acc[a][b][m][n] = (f32x4){0.f, 0.f, 0.f, 0.f};
        cur = nxt; cA = nA; cB = nB; ++ui;
        if constexpr (GATHER) { const u32x4 q = *(const LAS u32x4*)(pk + 16); *(LAS u32x4*)pk = q; }
        if constexpr (ALIGN_EPI) { if (wr == 1) PG8_BAR; }
    }
    PG8_WAIT_V(0);
    if constexpr (!ALIGN_EPI) { if (wr == 0) PG8_BAR; }
    PG8_BAR;
#undef PG8_SA
#undef PG8_SB
#undef PG8_STAGE_A
#undef PG8_STAGE_B
#undef PG8_LDA
#undef PG8_LDB
#undef PG8_MMA
#undef PG8_WAIT_V
#undef PG8_WAIT_L
#undef PG8_BAR
#undef PG8_SCHED
}
}

struct DenseSched {
    const bf16* A; const bf16* B; int K, nM, nN, G, c;
    __device__ __forceinline__ bool next(int i, WUnit& u) const {
        const int nwg = nM * nN; const int Lx = i * G + c; if (Lx >= nwg) return false;
        int wgid = Lx; { const int q = nwg / 8, r = nwg % 8, xcd = wgid % 8, off = wgid / 8; wgid = (xcd < r ? xcd * (q + 1) : r * (q + 1) + (xcd - r) * q) + off; }
        const int nig = 4 * nN, gid = wgid / nig, fm = gid * 4, gsz = (nM - fm) < 4 ? (nM - fm) : 4;
        u.pm = fm + ((wgid % nig) % gsz); u.pn = (wgid % nig) / gsz;
        u.A = A + (size_t)u.pm * 256 * K; u.B = B + (size_t)u.pn * 256 * K; u.gidx = nullptr; u.info = nullptr; u.ex = 0; u.nrows = 256; return true;
    }
};
struct FillSched {
    const bf16* A; const bf16* B; int K, nM, nN, G, c, R;
    __device__ __forceinline__ bool next(int i, WUnit& u) const {
        const int Gp = G - R; if (c < R || Gp <= 0) return false;
        const int nwg = nM * nN; const int Lx = i * Gp + (c - R); if (Lx >= nwg) return false;
        u.pm = Lx / nN; u.pn = Lx - u.pm * nN;
        u.A = A + (size_t)u.pm * 256 * K; u.B = B + (size_t)u.pn * 256 * K; u.gidx = nullptr; u.info = nullptr; u.ex = 0; u.nrows = 256; return true;
    }
};
struct MoeSched {
    const bf16* A; const bf16* Bw; const int* rowinfo; const LAS int* pre; int K, NPN, G, c; size_t bstride; bool gather;
    __device__ __forceinline__ bool next(int i, WUnit& u) const {
        const int tot = pre[32] * NPN; int Lx = i * G + c; if (Lx >= tot) return false;
        { const int q = tot / 8, r = tot % 8, xcd = Lx % 8, off = Lx / 8; Lx = (xcd < r ? xcd * (q + 1) : r * (q + 1) + (xcd - r) * q) + off; }
        const int gm = Lx / NPN; u.pn = Lx - gm * NPN; int e = 0;
        for (int j = 1; j < 32; ++j) e += (pre[j] <= gm) ? 1 : 0;
        u.ex = e; const int mt = gm - pre[e]; u.pm = gm; const int ne = pre[40 + e]; const int left = ne - 256 * mt; u.nrows = left < 256 ? left : 256;
        u.B = Bw + (size_t)e * bstride + (size_t)u.pn * 256 * K;
        u.info = rowinfo + (size_t)e * T + 256 * mt;
        if (gather) { u.A = A; u.gidx = u.info; } else { u.A = A + (size_t)gm * 256 * K; u.gidx = nullptr; }
        return true;
    }
};

#define EPI_LOOP _Pragma("unroll") for (int ai = 0; ai < 2; ++ai) _Pragma("unroll") for (int m = 0; m < 4; ++m) _Pragma("unroll") for (int n = 0; n < 2; ++n)
#define EPI_RC const int r = 128 * ai + 64 * wr + 16 * m + fr; const int c = 32 * wc + 16 * n + 4 * fq;
typedef f32x4 AccT[2][2][4][2];

#ifndef EPI_SC1
#define EPI_SC1 0
#endif
__device__ __forceinline__ void st16(bf16* base, size_t elem, const u32x4 v) {
#if EPI_SC1
    const __amdgpu_buffer_rsrc_t r = __builtin_amdgcn_make_buffer_rsrc(base, 0, 0x7fffffff, 0x00020000);
    __builtin_amdgcn_raw_buffer_store_b128(v, r, (int)(unsigned)(elem * 2), 0, 16);
#else
    *(u32x4*)(base + elem) = v;
#endif
}
__device__ __forceinline__ u32x4 pack8(const f32x4 a, const f32x4 b) { u32x4 w; w.x = cvtpk(a[0], a[1]); w.y = cvtpk(a[2], a[3]); w.z = cvtpk(b[0], b[1]); w.w = cvtpk(b[2], b[3]); return w; }
__device__ __forceinline__ void unpack8(const u32x4 w, f32x4& a, f32x4& b) { a[0] = bflo(w.x); a[1] = bfhi(w.x); a[2] = bflo(w.y); a[3] = bfhi(w.y); b[0] = bflo(w.z); b[1] = bfhi(w.z); b[2] = bflo(w.w); b[3] = bfhi(w.w); }
struct EpiGLU {
    const float* x; const float* bias; bf16* out;
    __device__ __forceinline__ void operator()(const AccT& acc, const WUnit& u, int wr, int wc, int fr, int fq) const {
        const int col = 128 * u.pn + 32 * wc + 8 * fq;
        f32x4 bv[2], bg[2];
#pragma unroll
        for (int n = 0; n < 2; ++n) { bv[n] = *(const f32x4*)(bias + col + 4 * n); bg[n] = *(const f32x4*)(bias + 2048 + col + 4 * n); }
#pragma unroll
        for (int ai = 0; ai < 2; ++ai) {
            f32x4 xv[4][2];
#pragma unroll
            for (int m = 0; m < 4; ++m)
#pragma unroll
                for (int n = 0; n < 2; ++n) xv[m][n] = *(const f32x4*)(x + ((size_t)u.pm * 256 + 128 * ai + 64 * wr + 16 * m + fr) * D + col + 4 * n);
#pragma unroll
            for (int m = 0; m < 4; ++m) { const size_t row = (size_t)u.pm * 256 + 128 * ai + 64 * wr + 16 * m + fr; f32x4 o[2];
#pragma unroll
                for (int n = 0; n < 2; ++n) { const f32x4 v = acc[ai][0][m][n] + bv[n], g = acc[ai][1][m][n] + bg[n];
#pragma unroll
                    for (int i = 0; i < 4; ++i) o[n][i] = xv[m][n][i] + v[i] * sigmoidf_(g[i]); }
                st16(out, row * D + col, pack8(o[0], o[1])); }
        }
    }
};
struct EpiStore {
    bf16* out; int ldc;
    __device__ __forceinline__ void operator()(const AccT& acc, const WUnit& u, int wr, int wc, int fr, int fq) const {
#pragma unroll
        for (int ai = 0; ai < 2; ++ai)
#pragma unroll
            for (int m = 0; m < 4; ++m) { const size_t row = (size_t)u.pm * 256 + 128 * ai + 64 * wr + 16 * m + fr;
#pragma unroll
                for (int bj = 0; bj < 2; ++bj) st16(out, row * ldc + 256 * u.pn + 128 * bj + 32 * wc + 8 * fq, pack8(acc[ai][bj][m][0], acc[ai][bj][m][1])); }
    }
};
struct EpiGateUp {
    const float* rr; const float* rw; bf16* hid; const int* rinfo0;
    __device__ __forceinline__ void operator()(const AccT& acc, const WUnit& u, int wr, int wc, int fr, int fq) const {
        const size_t lbase = (size_t)(u.info - rinfo0);
#pragma unroll
        for (int ai = 0; ai < 2; ++ai)
#pragma unroll
            for (int mp = 0; mp < 2; ++mp) {
                float sr[2], sw[2];
#pragma unroll
                for (int mm = 0; mm < 2; ++mm) { const int r = 128 * ai + 64 * wr + 16 * (2 * mp + mm) + fr; const bool ok = r < u.nrows; sr[mm] = ok ? rr[lbase + r] : 0.f; sw[mm] = ok ? rw[lbase + r] : 0.f; }
#pragma unroll
                for (int mm = 0; mm < 2; ++mm) { const int m = 2 * mp + mm; const int r = 128 * ai + 64 * wr + 16 * m + fr; f32x4 o[2];
#pragma unroll
                    for (int n = 0; n < 2; ++n) { const f32x4 g = acc[ai][0][m][n] * sr[mm], up = acc[ai][1][m][n] * sr[mm];
#pragma unroll
                        for (int i = 0; i < 4; ++i) o[n][i] = (g[i] * sigmoidf_(g[i])) * up[i] * sw[mm]; }
                    st16(hid, ((size_t)u.pm * 256 + r) * 512 + 128 * u.pn + 32 * wc + 8 * fq, pack8(o[0], o[1])); }
            }
    }
};
struct EpiDown {
    bf16* slot;
    __device__ __forceinline__ void operator()(const AccT& acc, const WUnit& u, int wr, int wc, int fr, int fq) const {
        int inf[2][4];
#pragma unroll
        for (int ai = 0; ai < 2; ++ai)
#pragma unroll
            for (int m = 0; m < 4; ++m) { const int r = 128 * ai + 64 * wr + 16 * m + fr; inf[ai][m] = (r < u.nrows) ? u.info[r] : -1; }
#pragma unroll
        for (int ai = 0; ai < 2; ++ai)
#pragma unroll
            for (int m = 0; m < 4; ++m) { const int info = inf[ai][m];
                if (info >= 0) { const size_t tok = (size_t)(info >> 1), sl = (size_t)(info & 1);
                    const size_t o = (sl * T + tok) * D + 256 * u.pn + 32 * wc + 8 * fq;
#pragma unroll
                    for (int bj = 0; bj < 2; ++bj) st16(slot, o + 128 * bj, pack8(acc[ai][bj][m][0], acc[ai][bj][m][1])); } }
    }
};
struct EpiPLE {
    const bf16* hin; const bf16* pp; const float* rs; bf16* hout; float* part;
    __device__ __forceinline__ void operator()(const AccT& acc, const WUnit& u, int wr, int wc, int fr, int fq) const {
#pragma unroll
        for (int ai = 0; ai < 2; ++ai) {
            u32x4 hv[4][2], pv[4][2]; float sr[4];
#pragma unroll
            for (int m = 0; m < 4; ++m) { const size_t row = (size_t)u.pm * 256 + 128 * ai + 64 * wr + 16 * m + fr; sr[m] = rs[row];
#pragma unroll
                for (int bj = 0; bj < 2; ++bj) { const int col = 256 * u.pn + 128 * bj + 32 * wc + 8 * fq;
                    hv[m][bj] = *(const u32x4*)(hin + row * D + col); pv[m][bj] = *(const u32x4*)(pp + row * D + col); } }
#pragma unroll
            for (int m = 0; m < 4; ++m) { const size_t row = (size_t)u.pm * 256 + 128 * ai + 64 * wr + 16 * m + fr; float ss = 0.f;
#pragma unroll
                for (int bj = 0; bj < 2; ++bj) { const int col = 256 * u.pn + 128 * bj + 32 * wc + 8 * fq;
                    f32x4 h[2], p[2], o[2]; unpack8(hv[m][bj], h[0], h[1]); unpack8(pv[m][bj], p[0], p[1]);
#pragma unroll
                    for (int n = 0; n < 2; ++n) { const f32x4 av = acc[ai][bj][m][n];
#pragma unroll
                        for (int i = 0; i < 4; ++i) { o[n][i] = h[n][i] + sigmoidf_(sr[m] * av[i]) * p[n][i]; ss += o[n][i] * o[n][i]; } }
                    st16(hout, row * D + col, pack8(o[0], o[1])); }
                ss += __shfl_xor(ss, 16); ss += __shfl_xor(ss, 32);
                if (fq == 0) part[row * 32 + 4 * u.pn + wc] = ss; }
        }
    }
};
struct EpiQKV {
    const float* part; const float* rope; bf16* q; bf16* kb; bf16* vb;
    __device__ __forceinline__ void operator()(const AccT& acc, const WUnit& u, int wr, int wc, int fr, int fq) const {
        const bool rot = u.pn < 28;
        const int c = 32 * wc + 8 * fq, hsel = c >> 6, d = c & 63;
        const unsigned* rp = (const unsigned*)rope;
#pragma unroll
        for (int ai = 0; ai < 2; ++ai) {
            f32x4 p0[4], p1[4]; u32x4 cs[4][2];
#pragma unroll
            for (int m = 0; m < 4; ++m) { const size_t row = (size_t)u.pm * 256 + 128 * ai + 64 * wr + 16 * m + fr; const int pos = (int)(row & (SEQ - 1));
                p0[m] = *(const f32x4*)(part + row * 32 + 8 * fq); p1[m] = *(const f32x4*)(part + row * 32 + 8 * fq + 4);
                if (rot) { cs[m][0] = *(const u32x4*)(rp + (size_t)pos * 64 + d); cs[m][1] = *(const u32x4*)(rp + (size_t)pos * 64 + d + 4); }
                else { cs[m][0] = (u32x4){0x3f80u, 0x3f80u, 0x3f80u, 0x3f80u}; cs[m][1] = cs[m][0]; } }
#pragma unroll
            for (int m = 0; m < 4; ++m) { const size_t row = (size_t)u.pm * 256 + 128 * ai + 64 * wr + 16 * m + fr;
                float ss = ((p0[m][0] + p0[m][1]) + (p0[m][2] + p0[m][3])) + ((p1[m][0] + p1[m][1]) + (p1[m][2] + p1[m][3]));
                ss += __shfl_xor(ss, 16); ss += __shfl_xor(ss, 32);
                const float sr = rsqrtf(ss * (1.f / D) + EPS);
                f32x4 o1[2], o2[2];
#pragma unroll
                for (int n = 0; n < 2; ++n) { const f32x4 a1 = acc[ai][0][m][n] * sr, a2 = acc[ai][1][m][n] * sr;
                    if (rot) {
#pragma unroll
                        for (int i = 0; i < 4; ++i) { const unsigned w = cs[m][n][i]; const float co = bflo(w), si = bfhi(w); o1[n][i] = a1[i] * co - a2[i] * si; o2[n][i] = a2[i] * co + a1[i] * si; }
                    } else { o1[n] = a1; o2[n] = a2; } }
                if (u.pn < 24) { const size_t o = row * 6144 + (size_t)(2 * u.pn + hsel) * 128 + d; st16(q, o, pack8(o1[0], o1[1])); st16(q, o + 64, pack8(o2[0], o2[1])); }
                else if (rot) { const size_t o = row * 1024 + (size_t)(2 * (u.pn - 24) + hsel) * 128 + d; st16(kb, o, pack8(o1[0], o1[1])); st16(kb, o + 64, pack8(o2[0], o2[1])); }
                else { const size_t o = row * 1024 + 256 * (u.pn - 28) + c; st16(vb, o, pack8(o1[0], o1[1])); st16(vb, o + 128, pack8(o2[0], o2[1])); }
            }
        }
    }
};
struct EpiResAdd {
    const bf16* hin; bf16* hout;
    __device__ __forceinline__ void operator()(const AccT& acc, const WUnit& u, int wr, int wc, int fr, int fq) const {
        u32x4 hv[2][4][2];
#pragma unroll
        for (int ai = 0; ai < 2; ++ai)
#pragma unroll
            for (int m = 0; m < 4; ++m)
#pragma unroll
                for (int bj = 0; bj < 2; ++bj) hv[ai][m][bj] = *(const u32x4*)(hin + ((size_t)u.pm * 256 + 128 * ai + 64 * wr + 16 * m + fr) * D + 256 * u.pn + 128 * bj + 32 * wc + 8 * fq);
#pragma unroll
        for (int ai = 0; ai < 2; ++ai)
#pragma unroll
            for (int m = 0; m < 4; ++m) { const size_t row = (size_t)u.pm * 256 + 128 * ai + 64 * wr + 16 * m + fr;
#pragma unroll
                for (int bj = 0; bj < 2; ++bj) { f32x4 h[2]; unpack8(hv[ai][m][bj], h[0], h[1]);
                    st16(hout, row * D + 256 * u.pn + 128 * bj + 32 * wc + 8 * fq, pack8(h[0] + acc[ai][bj][m][0], h[1] + acc[ai][bj][m][1])); } }
    }
};

struct Args { const float* in[31]; float* out; unsigned char* ws; int ph_lo, ph_hi; };

constexpr int CV_KBW = 4, CV_NBW = 2;
struct TrDesc { const float* W; bf16* dst; const float* gain; int ldn, k0, n0, K, drow0; float scale; };
enum { MAP_PLAIN = 0, MAP_HALF0 = 1, MAP_HALF1 = 2, MAP_ROPE = 3 };
__device__ __forceinline__ int map_row(int mode, int n0) {
    if (mode == MAP_PLAIN) return n0;
    if (mode == MAP_HALF0) return 256 * (n0 >> 7) + (n0 & 127);
    if (mode == MAP_HALF1) return 256 * (n0 >> 7) + 128 + (n0 & 127);
    const int head = n0 >> 7, d = n0 & 127; return 256 * (head >> 1) + 128 * (d >> 6) + 64 * (head & 1) + (d & 63);
}
__device__ __forceinline__ TrDesc mk_desc(const float* W, int ldn, int K, int ncols, bf16* dst, int drow_base, int mode, const float* gain, float scale, int it) {
    const int nblk = ncols >> 6; const int grp = it >> 3, j = it & 7, ngn = nblk / CV_NBW, kg = grp / ngn, ng = grp - kg * ngn;
    const int kb = kg * CV_KBW + j / CV_NBW, nb = ng * CV_NBW + j % CV_NBW;
    TrDesc d; d.W = W; d.dst = dst; d.gain = gain; d.ldn = ldn; d.k0 = 64 * kb; d.n0 = 64 * nb; d.K = K; d.drow0 = drow_base + map_row(mode, 64 * nb); d.scale = scale; return d;
}
__device__ __forceinline__ void tr_load(const TrDesc& d, f32x4 (&v)[16], int lane) {
    const int kq = lane >> 4, n4 = lane & 15;
#pragma unroll
    for (int j = 0; j < 16; ++j) v[j] = __builtin_nontemporal_load((const f32x4*)(d.W + (size_t)(d.k0 + kq + 4 * j) * d.ldn + d.n0 + 4 * n4));
}
__device__ __forceinline__ void tr_finish(const TrDesc& d, const f32x4 (&v)[16], LAS unsigned char* scr, int lane) {
    const int kq = lane >> 4, n4 = lane & 15;
#pragma unroll
    for (int j = 0; j < 16; ++j) { float g = d.scale; if (d.gain) g *= d.gain[d.k0 + kq + 4 * j];
        u32x2 w; w.x = cvtpk(v[j][0] * g, v[j][1] * g); w.y = cvtpk(v[j][2] * g, v[j][3] * g);
        *(LAS u32x2*)(scr + (kq + 4 * j) * 192 + n4 * 8) = w; }
    LDS_WAIT();
    const int G4 = lane >> 4, li = lane & 15, q = li >> 2, p = li & 3;
    u32x2 t[16];
#pragma unroll
    for (int r = 0; r < 16; ++r) t[r] = __builtin_bit_cast(u32x2, __builtin_amdgcn_ds_read_tr16_b64_v4i16((LAS s16x4*)(scr + (4 * r + q) * 192 + (16 * G4 + 4 * p) * 2)));
    bf16* o = d.dst + ((size_t)(d.drow0 >> 6) * (d.K >> 6) + (d.k0 >> 6)) * 4096 + (16 * G4 + li) * 64;
#pragma unroll
    for (int c = 0; c < 8; ++c) { u32x4 w; w.x = t[2 * c].x; w.y = t[2 * c].y; w.z = t[2 * c + 1].x; w.w = t[2 * c + 1].y; *(u32x4*)(o + 8 * c) = w; }
    LDS_WAIT();
}
struct MoeItems {
    const float* wg; const float* wu; const float* wd; const float* gain; bf16* WGU; bf16* WDN;
    __device__ __forceinline__ int count() const { return 32 * 768; }
    __device__ __forceinline__ TrDesc operator()(int it) const {
        const int e = it / 768, rem = it - e * 768, kind = rem >> 8, sub = rem & 255;
        if (kind == 0)      return mk_desc(wg + (size_t)e * 2048 * 512, 512, 2048, 512, WGU + (size_t)e * 1024 * 2048, 0, MAP_HALF0, gain, 1.f, sub);
        else if (kind == 1) return mk_desc(wu + (size_t)e * 2048 * 512, 512, 2048, 512, WGU + (size_t)e * 1024 * 2048, 0, MAP_HALF1, gain, 1.f, sub);
        return mk_desc(wd + (size_t)e * 512 * 2048, 2048, 512, 2048, WDN + (size_t)e * 2048 * 512, 0, MAP_PLAIN, nullptr, 1.f, sub);
    }
};
struct DenseItems {
    const Args* a; unsigned char* ws;
    __device__ __forceinline__ int count() const { return 9472; }
    __device__ __forceinline__ TrDesc operator()(int it) const {
        const float* const* in = a->in;
        bf16* WGLU = (bf16*)(ws + WS_WGLU); bf16* WQKV = (bf16*)(ws + WS_WQKV); bf16* WO = (bf16*)(ws + WS_WO); bf16* WPG = (bf16*)(ws + WS_WPG); bf16* WPP = (bf16*)(ws + WS_WPP);
        if (it < 1024) return mk_desc(in[11], 4096, 2048, 2048, WGLU, 0, MAP_HALF0, nullptr, 1.f, it); it -= 1024;
        if (it < 1024) return mk_desc(in[11] + 2048, 4096, 2048, 2048, WGLU, 0, MAP_HALF1, nullptr, 1.f, it); it -= 1024;
        if (it < 3072) return mk_desc(in[17], 6144, 2048, 6144, WQKV, 0, MAP_ROPE, in[16], 0.08838834764831845f, it); it -= 3072;
        if (it < 512) return mk_desc(in[14], 1024, 2048, 1024, WQKV, 6144, MAP_ROPE, in[13], 1.f, it); it -= 512;
        if (it < 512) return mk_desc(in[15], 1024, 2048, 1024, WQKV, 7168, MAP_PLAIN, in[13], 1.f, it); it -= 512;
        if (it < 1024) return mk_desc(in[18], 2048, 2048, 2048, WO, 0, MAP_PLAIN, nullptr, 1.f, it); it -= 1024;
        if (it < 1024) return mk_desc(in[28], 2048, 2048, 2048, WPG, 0, MAP_PLAIN, in[27], 1.f, it); it -= 1024;
        if (it < 128) return mk_desc(in[29], 2048, 256, 2048, WPP, 0, MAP_PLAIN, nullptr, 1.f, it); it -= 128;
        if (it < 1024) return mk_desc(in[28] + (size_t)2048 * 2048, 2048, 2048, 2048, WPG + (size_t)2048 * 2048, 0, MAP_PLAIN, in[27] + D, 1.f, it); it -= 1024;
        return mk_desc(in[29] + (size_t)256 * 2048, 2048, 256, 2048, WPP + (size_t)2048 * 256, 0, MAP_PLAIN, nullptr, 1.f, it);
    }
};
template <class Items>
__device__ __forceinline__ void run_items(const Items& I, int gw, int NGW, LAS unsigned char* scr, int lane) {
    const int n = I.count(); int it = gw; if (it >= n) return;
    TrDesc cur = I(it); f32x4 v[16]; tr_load(cur, v, lane);
    for (;;) {
        const int nx = it + NGW; const bool more = nx < n;
        TrDesc nd = cur; f32x4 w[16];
        if (more) { nd = I(nx); tr_load(nd, w, lane); }
        tr_finish(cur, v, scr, lane);
        if (!more) break;
#pragma unroll
        for (int j = 0; j < 16; ++j) v[j] = w[j];
        cur = nd; it = nx;
    }
}
__device__ __forceinline__ void moe_weights(const Args& a, int layer, int gw, int NGW, LAS unsigned char* scr, int lane) {
    MoeItems I{a.in[24] + (size_t)layer * 32 * 2048 * 512, a.in[25] + (size_t)layer * 32 * 2048 * 512, a.in[26] + (size_t)layer * 32 * 512 * 2048, a.in[19] + layer * D, (bf16*)(a.ws + WS_WGU), (bf16*)(a.ws + WS_WDN)};
    run_items(I, gw, NGW, scr, lane);
}

__device__ __forceinline__ void p0_prologue(const Args& a, LAS unsigned char* lds, int vcu, int G) {
    const int tid = threadIdx.x, lane = tid & 63, wave = __builtin_amdgcn_readfirstlane(tid >> 6);
    LAS unsigned char* scr = lds + wave * 16384;
    const int gw = vcu * NWAVES + wave, NGW = G * NWAVES;
    unsigned char* ws = a.ws;
    { DenseItems I{&a, ws}; run_items(I, gw, NGW, scr, lane); }
    {
        const float* x = a.in[0]; const float* g = a.in[2]; bf16* U0 = (bf16*)(ws + WS_U0);
        for (int row = gw; row < T; row += NGW) {
            const float* xr = x + (size_t)row * D; f32x4 v[4][2]; float ss = 0.f;
#pragma unroll
            for (int j = 0; j < 4; ++j) { v[j][0] = __builtin_nontemporal_load((const f32x4*)(xr + j * 512 + lane * 8)); v[j][1] = __builtin_nontemporal_load((const f32x4*)(xr + j * 512 + lane * 8 + 4));
#pragma unroll
                for (int h = 0; h < 2; ++h) ss += (v[j][h][0] * v[j][h][0] + v[j][h][1] * v[j][h][1]) + (v[j][h][2] * v[j][h][2] + v[j][h][3] * v[j][h][3]); }
            const float r = rsqrtf(wave_sum(ss) * (1.f / D) + EPS);
#pragma unroll
            for (int j = 0; j < 4; ++j) { const f32x4 g0 = *(const f32x4*)(g + j * 512 + lane * 8), g1 = *(const f32x4*)(g + j * 512 + lane * 8 + 4);
                u32x4 w; w.x = cvtpk(v[j][0][0] * r * g0[0], v[j][0][1] * r * g0[1]); w.y = cvtpk(v[j][0][2] * r * g0[2], v[j][0][3] * r * g0[3]);
                w.z = cvtpk(v[j][1][0] * r * g1[0], v[j][1][1] * r * g1[1]); w.w = cvtpk(v[j][1][2] * r * g1[2], v[j][1][3] * r * g1[3]);
                *(u32x4*)(U0 + (size_t)row * D + j * 512 + lane * 8) = w; }
        }
    }
    const int gt = vcu * NTHR + tid, NGT = G * NTHR;
    {
        const float* p = a.in[1]; bf16* PB = (bf16*)(ws + WS_PBF);
        for (int i = gt; i < 2 * T * 256 / 8; i += NGT) { const f32x4 v0 = __builtin_nontemporal_load((const f32x4*)(p + (size_t)i * 8)), v1 = __builtin_nontemporal_load((const f32x4*)(p + (size_t)i * 8 + 4));
            u32x4 w; w.x = cvtpk(v0[0], v0[1]); w.y = cvtpk(v0[2], v0[3]); w.z = cvtpk(v1[0], v1[1]); w.w = cvtpk(v1[2], v1[3]); *(u32x4*)(PB + (size_t)i * 8) = w; }
    }
    {
        float* rope = (float*)(ws + WS_ROPE);
        for (int i = gt; i < SEQ * 64; i += NGT) { const int pos = i >> 6, d = i & 63;
            const float inv = __builtin_amdgcn_exp2f(-(float)d * (13.287712379549449f / 64.f));
            float xrev = (float)pos * inv * 0.15915494309189535f; xrev -= floorf(xrev);
            ((unsigned*)rope)[i] = cvtpk(__builtin_amdgcn_cosf(xrev), __builtin_amdgcn_sinf(xrev)); }
    }
    {
        bf16* S5B = (bf16*)(ws + WS_S5B); bf16* S5C = (bf16*)(ws + WS_S5C); float* LB = (float*)(ws + WS_LB);
        for (int i = gt; i < 128 * 64; i += NGT) { const int g = i >> 6, p = i & 63;
            const float are = a.in[3][i], aim = a.in[4][i], dt = __expf(a.in[5][g]);
            const float mag = __expf(are * dt); float xrev = aim * dt * 0.15915494309189535f; xrev -= floorf(xrev);
            const float lre = mag * __builtin_amdgcn_cosf(xrev), lim = mag * __builtin_amdgcn_sinf(xrev);
            LB[2 * i] = lre; LB[2 * i + 1] = lim;
            const float nre = lre - 1.f, nim = lim, den = 1.f / (are * are + aim * aim);
            const float cre = (nre * are + nim * aim) * den, cim = (nim * are - nre * aim) * den;
            for (int ch = 0; ch < 16; ++ch) { const float bre = a.in[6][(size_t)i * 16 + ch], bim = a.in[7][(size_t)i * 16 + ch];
                const float vre = cre * bre - cim * bim, vim = cre * bim + cim * bre;
                const int hi = ch >> 3, jj = ch & 7;
#pragma unroll
                for (int ri = 0; ri < 2; ++ri) { const int col = 2 * p + ri, j = col >> 5, ln = (col & 31) + 32 * hi;
                    S5B[(((size_t)g * 4 + j) * 64 + ln) * 8 + jj] = (bf16)(cvtpk(ri ? vim : vre, 0.f) & 0xffffu); } }
#pragma unroll
            for (int ri = 0; ri < 2; ++ri) { const int k = 2 * p + ri, kk = k >> 4, hi = (k >> 3) & 1, jj = k & 7;
                for (int n = 0; n < 32; ++n) { float v = 0.f; if (n < 16) v = ri ? -a.in[9][((size_t)g * 16 + n) * 64 + p] : a.in[8][((size_t)g * 16 + n) * 64 + p];
                    S5C[(((size_t)g * 8 + kk) * 64 + (n + 32 * hi)) * 8 + jj] = (bf16)(cvtpk(v, 0.f) & 0xffffu); } }
        }
        bf16* S5D = (bf16*)(ws + WS_S5D);
        for (int i = gt; i < 128 * 64; i += NGT) { const int g = i >> 6, ln = i & 63, n = ln & 31, hi = ln >> 5;
#pragma unroll
            for (int jj = 0; jj < 8; ++jj) { const int k = 8 * hi + jj; const float v = (n == k && n < 16) ? a.in[10][g * 16 + n] : 0.f; S5D[(size_t)i * 8 + jj] = (bf16)(cvtpk(v, 0.f) & 0xffffu); } }
    }
    {
        bf16* WR = (bf16*)(ws + WS_WR);
        for (int i = gt; i < 2 * 48 * 2048; i += NGT) { const int l = i / (48 * 2048), rem = i - l * 48 * 2048, n = rem >> 11, k = rem & 2047;
            float w = 0.f; if (n < 4) w = a.in[20][((size_t)l * 2048 + k) * 4 + n]; else if (n < 36) w = a.in[22][((size_t)l * 2048 + k) * 32 + (n - 4)];
            w *= a.in[19][l * D + k];
            const unsigned hi = cvtpk(w, 0.f) & 0xffffu; const float lo = w - __uint_as_float(hi << 16);
            WR[((size_t)(l * 2 + 0) * 48 + n) * 2048 + k] = (bf16)hi; WR[((size_t)(l * 2 + 1) * 48 + n) * 2048 + k] = (bf16)(cvtpk(lo, 0.f) & 0xffffu); }
    }
}

__device__ __forceinline__ void s5_phase(const Args& a, LAS unsigned char* lds, int vcu, int G) {
    const int tid = threadIdx.x, lane = tid & 63, wave = __builtin_amdgcn_readfirstlane(tid >> 6), hi = lane >> 5, ql = lane & 31;
    unsigned char* ws = a.ws;
    const bf16* U0 = (const bf16*)(ws + WS_U0); bf16* G0 = (bf16*)(ws + WS_G0);
    const int pr = wave & 3; const bool producer = wave < 4;
    LAS unsigned char* pbase = lds + pr * 36864;
    LAS float* BU = (LAS float*)pbase;
    LAS unsigned* SSb = (LAS unsigned*)(pbase + 16384);
    volatile LAS unsigned* flg = (volatile LAS unsigned*)(pbase + 16384 + 17408);
    for (int item = vcu; item < 256; item += G) {
        const int b = item >> 5, g = 4 * (item & 31) + pr;
        const size_t base = (size_t)b * SEQ * D + (size_t)g * 16;
        __syncthreads();
        if (lane < 4 && producer) flg[lane] = 0u;
        __syncthreads();
        if (producer) {
            bf16x8 bm[4];
#pragma unroll
            for (int j = 0; j < 4; ++j) bm[j] = *(const bf16x8*)((const bf16*)(ws + WS_S5B) + (((size_t)g * 4 + j) * 64 + lane) * 8);
            const f32x2 lam = *(const f32x2*)((const float*)(ws + WS_LB) + ((size_t)g * 64 + lane) * 2);
            float sre = 0.f, sim = 0.f;
            bf16x8 ua = *(const bf16x8*)(U0 + base + (size_t)ql * D + 8 * hi), ub = *(const bf16x8*)(U0 + base + (size_t)(32 + ql) * D + 8 * hi);
            auto pbody = [&](const int blk, bf16x8& ur) {
                const int t0 = blk * 32, buf = blk & 1;
                const bf16x8 uf = ur;
#pragma unroll
                for (int j = 0; j < 4; ++j) {
                    f32x16 acc;
#pragma unroll
                    for (int i = 0; i < 16; ++i) acc[i] = 0.f;
                    acc = __builtin_amdgcn_mfma_f32_32x32x16_bf16(uf, bm[j], acc, 0, 0, 0);
#pragma unroll
                    for (int i = 0; i < 16; ++i) BU[((i & 3) + 8 * (i >> 2) + 4 * hi) * 128 + 32 * j + ql] = acc[i];
                }
                { const int tn = (blk < 62) ? t0 + 64 : t0; ur = *(const bf16x8*)(U0 + base + (size_t)(tn + ql) * D + 8 * hi); }
                LDS_WAIT();
                f32x2 bu[32];
#pragma unroll
                for (int t = 0; t < 32; ++t) bu[t] = *(const LAS f32x2*)(BU + t * 128 + 2 * lane);
                if (blk >= 2) { while (flg[2 + buf] < (unsigned)(blk - 1)) __builtin_amdgcn_s_sleep(1); }
                asm volatile("" ::: "memory");
                LAS unsigned* SS = SSb + buf * (32 * 68);
#pragma unroll
                for (int t = 0; t < 32; ++t) {
                    const float nre = lam.x * sre - lam.y * sim + bu[t].x, nim = lam.x * sim + lam.y * sre + bu[t].y;
                    sre = nre; sim = nim;
                    SS[t * 68 + lane] = cvtpk(sre, sim);
                }
                LDS_WAIT();
                if (lane == 0) flg[buf] = (unsigned)(blk + 1);
            };
#pragma clang loop unroll(disable)
            for (int blk = 0; blk < 64; blk += 2) { pbody(blk, ua); pbody(blk + 1, ub); }
        } else {
            bf16x8 cm[8], dm;
#pragma unroll
            for (int kk = 0; kk < 8; ++kk) cm[kk] = *(const bf16x8*)((const bf16*)(ws + WS_S5C) + (((size_t)g * 8 + kk) * 64 + lane) * 8);
            dm = *(const bf16x8*)((const bf16*)(ws + WS_S5D) + ((size_t)g * 64 + lane) * 8);
            bf16x8 ufn = *(const bf16x8*)(U0 + base + (size_t)ql * D + 8 * hi);
            bf16x8 bsel[2];
#pragma unroll
            for (int s2 = 0; s2 < 2; ++s2) { const int jj = ql - 16 * s2 - 8 * hi; u32x4 w;
                w.x = jj == 0 ? 0x3f80u : jj == 1 ? 0x3f800000u : 0u; w.y = jj == 2 ? 0x3f80u : jj == 3 ? 0x3f800000u : 0u;
                w.z = jj == 4 ? 0x3f80u : jj == 5 ? 0x3f800000u : 0u; w.w = jj == 6 ? 0x3f80u : jj == 7 ? 0x3f800000u : 0u; bsel[s2] = __builtin_bit_cast(bf16x8, w); }
            const int cri = (ql & 3) + 4 * (ql >> 3) + 32 * ((ql >> 2) & 1);
            __builtin_amdgcn_s_waitcnt(0x0F70);
            auto body = [&](const int blk, const bf16x8& uf, bf16x8& ufnx, const bool cv) {
                const int t0 = blk * 32, buf = blk & 1;
                { const int tn = (blk < 63) ? t0 + 32 : t0; ufnx = *(const bf16x8*)(U0 + base + (size_t)(tn + ql) * D + 8 * hi); }
                f32x4 cvv[2][2][2]; float cg[2] = {1.f, 1.f}; bf16* cdst = nullptr; int cK = 0;
                if (cv) {
                    const int q = (3 * (blk >> 2) + (blk & 3)) * 1024 + item * 4 + pr;
                    const int e = q / 1536, r = q - e * 1536, kind = r >> 9, sub = r & 511;
                    const float* src; int ldn; const float* gp = a.in[19];
                    if (kind < 2) { const int kp = sub >> 4, n0 = 32 * (sub & 15);
                        src = a.in[24 + kind] + (size_t)e * 2048 * 512 + (size_t)(64 * kp) * 512 + n0; ldn = 512; cK = 2048;
                        { const int row0 = 256 * (n0 >> 7) + 128 * kind + (n0 & 127);
                          cdst = (bf16*)(ws + WS_WGU) + (size_t)e * 1024 * 2048 + (size_t)((row0 >> 6) * 32 + kp) * 4096 + (row0 & 63) * 64; }
                        gp += 64 * kp;
                    } else { const int kp = sub >> 6, n0 = 32 * (sub & 63);
                        src = a.in[26] + (size_t)e * 512 * 2048 + (size_t)(64 * kp) * 2048 + n0; ldn = 2048; cK = 512;
                        cdst = (bf16*)(ws + WS_WDN) + (size_t)e * 2048 * 512 + (size_t)((n0 >> 6) * 8 + kp) * 4096 + (n0 & 63) * 64; }
                    { const float g0 = gp[cri], g1 = gp[cri + 16]; cg[0] = kind < 2 ? g0 : 1.f; cg[1] = kind < 2 ? g1 : 1.f; }
#pragma unroll
                    for (int t = 0; t < 2; ++t)
#pragma unroll
                        for (int s2 = 0; s2 < 2; ++s2) { const float* p = src + (size_t)(cri + 16 * t) * ldn + 16 * s2 + 8 * hi;
                            cvv[t][s2][0] = *(const f32x4*)p; cvv[t][s2][1] = *(const f32x4*)(p + 4); }
                }
                while (flg[buf] < (unsigned)(blk + 1)) __builtin_amdgcn_s_sleep(1);
                asm volatile("" ::: "memory");
                const LAS unsigned* SS = SSb + buf * (32 * 68);
                bf16x8 sf[8];
#pragma unroll
                for (int kk = 0; kk < 8; ++kk) sf[kk] = *(const LAS bf16x8*)(SS + ql * 68 + 8 * kk + 4 * hi);
                LDS_WAIT();
                if (lane == 0) flg[2 + buf] = (unsigned)(blk + 1);
                f32x16 y;
#pragma unroll
                for (int i = 0; i < 16; ++i) y[i] = 0.f;
#pragma unroll
                for (int kk = 0; kk < 8; ++kk) y = __builtin_amdgcn_mfma_f32_32x32x16_bf16(sf[kk], cm[kk], y, 0, 0, 0);
                y = __builtin_amdgcn_mfma_f32_32x32x16_bf16(uf, dm, y, 0, 0, 0);
                LAS unsigned short* YT = (LAS unsigned short*)(pbase + 16384 + 17408 + 64 + (blk & 1) * 1024);
                if (ql < 16) {
#pragma unroll
                    for (int i = 0; i < 16; ++i) { const int tl = (i & 3) + 8 * (i >> 2) + 4 * hi; YT[tl * 16 + ql] = (unsigned short)(cvtpk(gelu_tanh(y[i]), 0.f) & 0xffffu); }
                }
                LDS_WAIT();
                { const u32x4 w0 = *(const LAS u32x4*)(YT + lane * 8);
                    bf16* o = G0 + base + (size_t)(t0 + (lane >> 1)) * D + 8 * (lane & 1); *(u32x4*)o = w0; }
                LDS_WAIT();
                if (cv) {
#pragma unroll
                    for (int t = 0; t < 2; ++t) { f32x16 ca;
#pragma unroll
                        for (int i = 0; i < 16; ++i) ca[i] = 0.f;
#pragma unroll
                        for (int s2 = 0; s2 < 2; ++s2) ca = __builtin_amdgcn_mfma_f32_32x32x16_bf16(__builtin_bit_cast(bf16x8, pack8(cvv[t][s2][0] * cg[t], cvv[t][s2][1] * cg[t])), bsel[s2], ca, 0, 0, 0);
                        bf16* o = cdst + ql * 64 + 32 * hi + 16 * t;
                        *(u32x4*)o = pack8((f32x4){ca[0], ca[1], ca[2], ca[3]}, (f32x4){ca[4], ca[5], ca[6], ca[7]});
                        *(u32x4*)(o + 8) = pack8((f32x4){ca[8], ca[9], ca[10], ca[11]}, (f32x4){ca[12], ca[13], ca[14], ca[15]}); }
                }
            };
            bf16x8 ufa = ufn, ufb = ufn;
#pragma clang loop unroll(disable)
            for (int blk = 0; blk < 64; blk += 4) { body(blk, ufa, ufb, true); body(blk + 1, ufb, ufa, true); body(blk + 2, ufa, ufb, true); body(blk + 3, ufb, ufa, false); }
        }
    }
}

__device__ __forceinline__ void router_phase(const Args& a, int layer, const bf16* H, LAS unsigned char* lds, int vcu, int G, unsigned* rdone) {
    const int tid = threadIdx.x, lane = tid & 63, wave = __builtin_amdgcn_readfirstlane(tid >> 6), fr = lane & 15, fq = lane >> 4;
    unsigned char* ws = a.ws;
    const bf16* WR = (const bf16*)(ws + WS_WR) + (size_t)layer * 2 * 48 * 2048;
    LAS float* red = (LAS float*)lds;
    LAS float* fin = (LAS float*)(lds + 106496);
    const float* gb = a.in[21] + layer * 4; const float* eb = a.in[23] + layer * 32;
    for (int item = vcu; item < T / 64; item += G) {
        const int t0 = item * 64;
        f32x4 acc[4][3];
#pragma unroll
        for (int mt = 0; mt < 4; ++mt)
#pragma unroll
            for (int i = 0; i < 3; ++i) acc[mt][i] = (f32x4){0.f, 0.f, 0.f, 0.f};
        float ss[4] = {0.f, 0.f, 0.f, 0.f};
        const bf16* hp = H + (size_t)(t0 + fr) * D + wave * 256 + 8 * fq;
        const bf16* wp = WR + (size_t)fr * 2048 + wave * 256 + 8 * fq;
#pragma unroll 2
        for (int ks = 0; ks < 8; ++ks) {
            bf16x8 af[4], wh[3], wl[3];
#pragma unroll
            for (int mt = 0; mt < 4; ++mt) af[mt] = *(const bf16x8*)(hp + (size_t)mt * 16 * D + ks * 32);
#pragma unroll
            for (int nt = 0; nt < 3; ++nt) { wh[nt] = *(const bf16x8*)(wp + (size_t)nt * 16 * 2048 + ks * 32); wl[nt] = *(const bf16x8*)(wp + (size_t)(48 + nt * 16) * 2048 + ks * 32); }
#pragma unroll
            for (int mt = 0; mt < 4; ++mt) {
                const u32x4 au = __builtin_bit_cast(u32x4, af[mt]);
#pragma unroll
                for (int i = 0; i < 4; ++i) { const float lo = bflo(au[i]), hi2 = bfhi(au[i]); ss[mt] += lo * lo + hi2 * hi2; }
#pragma unroll
                for (int nt = 0; nt < 3; ++nt) {
                    acc[mt][nt] = __builtin_amdgcn_mfma_f32_16x16x32_bf16(wh[nt], af[mt], acc[mt][nt], 0, 0, 0);
                    acc[mt][nt] = __builtin_amdgcn_mfma_f32_16x16x32_bf16(wl[nt], af[mt], acc[mt][nt], 0, 0, 0);
                }
            }
        }
#pragma unroll
        for (int mt = 0; mt < 4; ++mt) {
#pragma unroll
            for (int nt = 0; nt < 3; ++nt) *(LAS f32x4*)(red + (wave * 64 + 16 * mt + fr) * 52 + 16 * nt + 4 * fq) = acc[mt][nt];
            float s1 = ss[mt]; s1 += __shfl_xor(s1, 16); s1 += __shfl_xor(s1, 32);
            if (fq == 0) red[(wave * 64 + 16 * mt + fr) * 52 + 48] = s1;
        }
        __syncthreads();
        for (int i = tid; i < 64 * 49; i += NTHR) { const int tk = i / 49, e = i - tk * 49; float sum = 0.f;
#pragma unroll
            for (int w = 0; w < 8; ++w) sum += red[(w * 64 + tk) * 52 + e];
            fin[tk * 52 + e] = sum; }
        __syncthreads();
        if (tid < 64) {
            const LAS float* f = fin + tid * 52; const int tok = t0 + tid;
            const float sr = rsqrtf(f[48] * (1.f / D) + EPS);
            float gl[4];
#pragma unroll
            for (int j = 0; j < 4; ++j) gl[j] = sr * f[j] + gb[j];
            int gi = 0; float gm = gl[0];
#pragma unroll
            for (int j = 1; j < 4; ++j) if (gl[j] > gm) { gm = gl[j]; gi = j; }
            float gs = 0.f;
#pragma unroll
            for (int j = 0; j < 4; ++j) gs += __expf(gl[j] - gm);
            const float gprob = 1.f / gs;
            int i0 = 0, i1 = 0; float v0 = -3.0e38f, v1 = -3.0e38f;
            for (int j = 0; j < 8; ++j) { const float v = sr * f[4 + 8 * gi + j] + eb[8 * gi + j];
                if (v > v0) { v1 = v0; i1 = i0; v0 = v; i0 = j; } else if (v > v1) { v1 = v; i1 = j; } }
            const float ex = __expf(v1 - v0); const float w0 = gprob / (1.f + ex), w1 = gprob * ex / (1.f + ex);
            const int e0 = 8 * gi + i0, e1 = 8 * gi + i1;
            u32x4 rec; rec.x = (unsigned)(e0 | (e1 << 8)); rec.y = __float_as_uint(w0); rec.z = __float_as_uint(w1); rec.w = __float_as_uint(sr);
            { const __amdgpu_buffer_rsrc_t rr_ = __builtin_amdgcn_make_buffer_rsrc((void*)(ws + WS_TOKREC), 0, 0x7fffffff, 0x00020000);
              __builtin_amdgcn_raw_buffer_store_b128(rec, rr_, tok * 16, 0, 16); }
        }
        __syncthreads();
    }
    asm volatile("s_waitcnt vmcnt(0)" ::: "memory");
    __syncthreads();
    if (threadIdx.x == 0) (void)xb_add(rdone, 1u);
}

__device__ __forceinline__ void build_lists(unsigned char* ws, unsigned* cnt, LAS unsigned char* lds, int vcu, int G) {
    const int tid = threadIdx.x, lane = tid & 63, wave = __builtin_amdgcn_readfirstlane(tid >> 6);
    const u32x4* rec = (const u32x4*)(ws + WS_TOKREC);
    int* rinfo = (int*)(ws + WS_RINFO); float* rw = (float*)(ws + WS_RW); float* rr = (float*)(ws + WS_RR);
    LAS int* sc = (LAS int*)lds;
    for (int e = vcu; e < 32; e += G) {
        unsigned m0 = 0u, m1 = 0u;
        for (int j = 0; j < 32; ++j) { const unsigned dec = rec[32 * tid + j].x; m0 |= ((dec & 255u) == (unsigned)e ? 1u : 0u) << j; m1 |= (((dec >> 8) & 255u) == (unsigned)e ? 1u : 0u) << j; }
        const int c = __popc(m0 | m1);
        int incl = c;
#pragma unroll
        for (int o = 1; o < 64; o <<= 1) { const int v = __shfl_up(incl, o); if (lane >= o) incl += v; }
        __syncthreads();
        if (lane == 63) sc[wave] = incl;
        __syncthreads();
        int wbase = 0, total = 0;
        for (int w = 0; w < 8; ++w) { const int v = sc[w]; total += v; if (w < wave) wbase += v; }
        size_t pos = (size_t)e * T + (size_t)(wbase + incl - c);
        unsigned mm = m0 | m1;
        while (mm) { const int j = __ffs(mm) - 1; mm &= mm - 1u; const int t = 32 * tid + j; const unsigned sl = (m1 >> j) & 1u; const u32x4 r = rec[t];
            rinfo[pos] = (t << 1) | (int)sl; rw[pos] = __uint_as_float(sl ? r.z : r.y); rr[pos] = __uint_as_float(r.w); ++pos; }
        if (tid == 0) cnt[e * 32] = (unsigned)total;
    }
}
__device__ __forceinline__ void moe_prefix(unsigned* cnt, LAS int* pre) {
    __syncthreads();
    if (threadIdx.x < 32) pre[40 + threadIdx.x] = (int)__hip_atomic_load(cnt + threadIdx.x * 32, __ATOMIC_RELAXED, __HIP_MEMORY_SCOPE_AGENT);
    __syncthreads();
    if (threadIdx.x == 0) { int s = 0; for (int e = 0; e < 32; ++e) { pre[e] = s; s += (pre[40 + e] + 255) >> 8; } pre[32] = s; }
    __syncthreads();
}

__device__ __forceinline__ void wait_routers(unsigned* rdone, unsigned G) {
    if (threadIdx.x == 0) { unsigned sp = 0u; while (xb_ld(rdone) < G && ++sp < XB_SPIN_CAP) __builtin_amdgcn_s_sleep(2);
        __builtin_amdgcn_fence(__ATOMIC_ACQUIRE, "agent"); }
    __syncthreads();
}
__device__ __forceinline__ void combine_phase(const bf16* hin, const bf16* slot, bf16* hout, float* rs, int vcu, int G) {
    const int tid = threadIdx.x, lane = tid & 63, wave = __builtin_amdgcn_readfirstlane(tid >> 6);
    const int gw = vcu * NWAVES + wave, NGW = G * NWAVES;
    for (int row = gw; row < T; row += NGW) {
        float ss = 0.f;
#pragma unroll
        for (int j = 0; j < 4; ++j) { const size_t off = (size_t)row * D + j * 512 + lane * 8;
            const u32x4 h = *(const u32x4*)(hin + off), s0 = *(const u32x4*)(slot + off), s1 = *(const u32x4*)(slot + (size_t)T * D + off); u32x4 w;
#pragma unroll
            for (int i = 0; i < 4; ++i) { const float lo = bflo(h[i]) + bflo(s0[i]) + bflo(s1[i]), hi2 = bfhi(h[i]) + bfhi(s0[i]) + bfhi(s1[i]); ss += lo * lo + hi2 * hi2; w[i] = cvtpk(lo, hi2); }
            *(u32x4*)(hout + off) = w; }
        ss = wave_sum(ss);
        if (lane == 0) rs[row] = rsqrtf(ss * (1.f / D) + EPS);
    }
}
__device__ __forceinline__ void final_phase(const bf16* hin, const float* g, float* out, int vcu, int G) {
    const int tid = threadIdx.x, lane = tid & 63, wave = __builtin_amdgcn_readfirstlane(tid >> 6);
    const int gw = vcu * NWAVES + wave, NGW = G * NWAVES;
    for (int row = gw; row < T; row += NGW) {
        float ss = 0.f; u32x4 h[4];
#pragma unroll
        for (int j = 0; j < 4; ++j) { h[j] = *(const u32x4*)(hin + (size_t)row * D + j * 512 + lane * 8);
#pragma unroll
            for (int i = 0; i < 4; ++i) { const float lo = bflo(h[j][i]), hi2 = bfhi(h[j][i]); ss += lo * lo + hi2 * hi2; } }
        const float r = rsqrtf(wave_sum(ss) * (1.f / D) + EPS);
#pragma unroll
        for (int j = 0; j < 4; ++j) { const f32x4 g0 = *(const f32x4*)(g + j * 512 + lane * 8), g1 = *(const f32x4*)(g + j * 512 + lane * 8 + 4); f32x4 o0, o1;
            o0[0] = bflo(h[j][0]) * r * g0[0]; o0[1] = bfhi(h[j][0]) * r * g0[1]; o0[2] = bflo(h[j][1]) * r * g0[2]; o0[3] = bfhi(h[j][1]) * r * g0[3];
            o1[0] = bflo(h[j][2]) * r * g1[0]; o1[1] = bfhi(h[j][2]) * r * g1[1]; o1[2] = bflo(h[j][3]) * r * g1[2]; o1[3] = bfhi(h[j][3]) * r * g1[3];
            __builtin_nontemporal_store(o0, (f32x4*)(out + (size_t)row * D + j * 512 + lane * 8)); __builtin_nontemporal_store(o1, (f32x4*)(out + (size_t)row * D + j * 512 + lane * 8 + 4)); }
    }
}

__device__ __forceinline__ int kvoff(int row, int ch) { return 256 * row + 16 * (ch ^ (((row & 3) << 2) | ((row >> 2) & 3))); }
__device__ __forceinline__ void attn_unit_params(int ui, int& pat, int& b, int& kvh, int& dsh, int& r, int& n) {
    const int x = ui & 15; kvh = (ui >> 4) & 7; b = (ui >> 7) & 7; pat = ui >> 10;
    dsh = 2 * pat; const int nsh = 4 - dsh;
    r = x >> nsh; n = x & ((1 << nsh) - 1);
}
__device__ __forceinline__ void attn_kv_load(const bf16* Kb, const bf16* Vb, int ui, int tid, u32x4 (&kr)[8], u32x4 (&vr)[8]) {
    int pat, b, kvh, dsh, r, n; attn_unit_params(ui, pat, b, kvh, dsh, r, n);
    const size_t rowbase = (size_t)b * SEQ;
#pragma unroll
    for (int pass = 0; pass < 8; ++pass) {
        const int row = pass * 32 + (tid >> 4), ch = tid & 15, spos = 128 * (n - 1) + row;
        if (spos >= 0) { const size_t tok = rowbase + ((size_t)spos << dsh) + r;
            kr[pass] = *(const u32x4*)(Kb + tok * 1024 + kvh * 128 + ch * 8); vr[pass] = *(const u32x4*)(Vb + tok * 1024 + kvh * 128 + ch * 8); }
    }
}
__device__ __forceinline__ void attn_phase(const Args& a, LAS unsigned char* lds, int vcu, int G) {
    const int tid = threadIdx.x, lane = tid & 63, wave = __builtin_amdgcn_readfirstlane(tid >> 6), hi = lane >> 5, ql = lane & 31;
    unsigned char* ws = a.ws;
    const bf16* Kb = (const bf16*)(ws + WS_KB); const bf16* Vb = (const bf16*)(ws + WS_VB); bf16* Q = (bf16*)(ws + WS_Q); float* lse = (float*)(ws + WS_LSE);
    LAS unsigned char* Ks = lds; LAS unsigned char* Vs = lds + 65536;
    const int i0w = 32 * (wave & 3);
    const int g4 = lane >> 4, li = lane & 15, tq = li >> 2, tp = li & 3;
    int kA[8], vA[2][4];
#pragma unroll
    for (int kk = 0; kk < 8; ++kk) kA[kk] = kvoff(i0w + ql, 2 * kk + hi);
#pragma unroll
    for (int h2 = 0; h2 < 2; ++h2)
#pragma unroll
        for (int dt = 0; dt < 4; ++dt) vA[h2][dt] = 65536 + kvoff(i0w + 4 * hi + tq + 8 * h2, 4 * dt + 2 * (g4 & 1) + (tp >> 1)) + 8 * (tp & 1);
    u32x4 kr[8], vr[8];
    if (vcu < 3072) attn_kv_load(Kb, Vb, vcu, tid, kr, vr);
    for (int ui = vcu; ui < 3072; ui += G) {
        int pat, b, kvh, dsh, r, n; attn_unit_params(ui, pat, b, kvh, dsh, r, n);
        const size_t rowbase = (size_t)b * SEQ;
        const int head = 2 * kvh + (wave >> 2), i0 = 32 * (wave & 3);
        const int sq = 128 * n + i0 + ql; const size_t tokq = rowbase + ((size_t)sq << dsh) + r;
        bf16* qrow = Q + tokq * 6144 + (size_t)(pat * 16 + head) * 128;
        bf16x8 qf[8];
#pragma unroll
        for (int kk = 0; kk < 8; ++kk) qf[kk] = *(const bf16x8*)(qrow + 16 * kk + 8 * hi);
#pragma unroll
        for (int pass = 0; pass < 8; ++pass) {
            const int row = pass * 32 + (tid >> 4), ch = tid & 15, spos = 128 * (n - 1) + row;
            if (spos >= 0) { *(LAS u32x4*)(Ks + kvoff(row, ch)) = kr[pass]; *(LAS u32x4*)(Vs + kvoff(row, ch)) = vr[pass]; }
        }
        __syncthreads();
        f32x16 S[5];
#pragma unroll
        for (int j = 0; j < 5; ++j) {
            const int kr0 = i0 + 32 * j; const bool valid = (n > 0) || (kr0 >= 128);
            f32x16 sacc;
#pragma unroll
            for (int i = 0; i < 16; ++i) sacc[i] = 0.f;
            if (valid) {
#pragma unroll
                for (int kk = 0; kk < 8; ++kk) { const bf16x8 kf = *(const LAS bf16x8*)(lds + kA[kk] + 8192 * j); sacc = __builtin_amdgcn_mfma_f32_32x32x16_bf16(kf, qf[kk], sacc, 0, 0, 0); }
            }
#pragma unroll
            for (int i = 0; i < 16; ++i) { const int c = (i & 3) + 8 * (i >> 2) + 4 * hi; bool ok = valid; if (j == 0) ok = ok && (c >= ql); if (j == 4) ok = ok && (c <= ql); sacc[i] = ok ? sacc[i] : -1e30f; }
            S[j] = sacc;
        }
        float mx = -1e30f;
#pragma unroll
        for (int j = 0; j < 5; ++j)
#pragma unroll
            for (int i = 0; i < 16; ++i) mx = fmaxf(mx, S[j][i]);
        mx = fmaxf(mx, __shfl_xor(mx, 32));
        float den = 0.f;
#pragma unroll
        for (int j = 0; j < 5; ++j)
#pragma unroll
            for (int i = 0; i < 16; ++i) { const float e = __builtin_amdgcn_exp2f((S[j][i] - mx) * 1.4426950408889634f); S[j][i] = e; den += e; }
        den += __shfl_xor(den, 32);
        bf16x8 pfr[5][2];
#pragma unroll
        for (int j = 0; j < 5; ++j)
#pragma unroll
            for (int s2 = 0; s2 < 2; ++s2) { u32x4 pw; pw.x = cvtpk(S[j][8 * s2 + 0], S[j][8 * s2 + 1]); pw.y = cvtpk(S[j][8 * s2 + 2], S[j][8 * s2 + 3]); pw.z = cvtpk(S[j][8 * s2 + 4], S[j][8 * s2 + 5]); pw.w = cvtpk(S[j][8 * s2 + 6], S[j][8 * s2 + 7]);
                pfr[j][s2] = __builtin_bit_cast(bf16x8, pw); }
        if (ui + G < 3072) attn_kv_load(Kb, Vb, ui + G, tid, kr, vr);
        f32x16 O[4];
#pragma unroll
        for (int dt = 0; dt < 4; ++dt)
#pragma unroll
            for (int i = 0; i < 16; ++i) O[dt][i] = 0.f;
#pragma unroll
        for (int j = 0; j < 5; ++j) {
            const int kr0 = i0 + 32 * j; const bool valid = (n > 0) || (kr0 >= 128);
            if (valid) {
#pragma unroll
                for (int s2 = 0; s2 < 2; ++s2) {
                    const bf16x8 pf = pfr[j][s2];
#pragma unroll
                    for (int dt = 0; dt < 4; ++dt) {
                        const s16x4 v0 = __builtin_amdgcn_ds_read_tr16_b64_v4i16((LAS s16x4*)(lds + vA[0][dt] + 8192 * j + 4096 * s2));
                        const s16x4 v1 = __builtin_amdgcn_ds_read_tr16_b64_v4i16((LAS s16x4*)(lds + vA[1][dt] + 8192 * j + 4096 * s2));
                        bf16x8 vf; vf[0] = v0[0]; vf[1] = v0[1]; vf[2] = v0[2]; vf[3] = v0[3]; vf[4] = v1[0]; vf[5] = v1[1]; vf[6] = v1[2]; vf[7] = v1[3];
                        O[dt] = __builtin_amdgcn_mfma_f32_32x32x16_bf16(vf, pf, O[dt], 0, 0, 0);
                    }
                }
            }
        }
        const float inv = __builtin_amdgcn_rcpf(den);
#pragma unroll
        for (int dt = 0; dt < 4; ++dt)
#pragma unroll
            for (int qp = 0; qp < 2; ++qp) {
                u32x2 we, wo;
                we.x = cvtpk(O[dt][8 * qp] * inv, O[dt][8 * qp + 1] * inv); we.y = cvtpk(O[dt][8 * qp + 2] * inv, O[dt][8 * qp + 3] * inv);
                wo.x = cvtpk(O[dt][8 * qp + 4] * inv, O[dt][8 * qp + 5] * inv); wo.y = cvtpk(O[dt][8 * qp + 6] * inv, O[dt][8 * qp + 7] * inv);
                const u32x2 give = hi ? we : wo;
                u32x2 got; got.x = (unsigned)__shfl_xor((int)give.x, 32); got.y = (unsigned)__shfl_xor((int)give.y, 32);
                u32x4 w16; if (hi) { w16.x = got.x; w16.y = got.y; w16.z = wo.x; w16.w = wo.y; } else { w16.x = we.x; w16.y = we.y; w16.z = got.x; w16.w = got.y; }
                *(u32x4*)(qrow + 32 * dt + 16 * qp + 8 * hi) = w16; }
        if (hi == 0) lse[((size_t)pat * T + tokq) * 16 + head] = mx + __logf(den);
        __syncthreads();
    }
}
__device__ __forceinline__ void merge_phase(const Args& a, int vcu, int G) {
    const int tid = threadIdx.x, lane = tid & 63, wave = __builtin_amdgcn_readfirstlane(tid >> 6);
    const int gw = vcu * NWAVES + wave, NGW = G * NWAVES;
    unsigned char* ws = a.ws; const bf16* Q = (const bf16*)(ws + WS_Q); const float* lse = (const float*)(ws + WS_LSE); bf16* O = (bf16*)(ws + WS_O);
    for (int row = gw; row < T; row += NGW) {
#pragma unroll
        for (int j = 0; j < 4; ++j) { const int head = 4 * j + (lane >> 4), d0 = (lane & 15) * 8;
            const float l0 = lse[((size_t)0 * T + row) * 16 + head], l1 = lse[((size_t)1 * T + row) * 16 + head], l2 = lse[((size_t)2 * T + row) * 16 + head];
            const float mx = fmaxf(l0, fmaxf(l1, l2)); float w0 = __expf(l0 - mx), w1 = __expf(l1 - mx), w2 = __expf(l2 - mx); const float inv = 1.f / (w0 + w1 + w2); w0 *= inv; w1 *= inv; w2 *= inv;
            const u32x4 o0 = *(const u32x4*)(Q + (size_t)row * 6144 + (0 * 16 + head) * 128 + d0), o1 = *(const u32x4*)(Q + (size_t)row * 6144 + (1 * 16 + head) * 128 + d0), o2 = *(const u32x4*)(Q + (size_t)row * 6144 + (2 * 16 + head) * 128 + d0);
            u32x4 w;
#pragma unroll
            for (int i = 0; i < 4; ++i) w[i] = cvtpk(w0 * bflo(o0[i]) + w1 * bflo(o1[i]) + w2 * bflo(o2[i]), w0 * bfhi(o0[i]) + w1 * bfhi(o1[i]) + w2 * bfhi(o2[i]));
            *(u32x4*)(O + (size_t)row * D + head * 128 + d0) = w; }
    }
}

#define GEMM_RUN(K, S, E) pg8::gemm_phase<false, true>(lds, K, S, E)
#define GEMM_RUN_G(K, S, E) pg8::gemm_phase<true, true>(lds, K, S, E)
#define GEMM_RUN_2ND(K, S, E) pg8::gemm_phase<false, true, true>(lds, K, S, E)
__global__ void __launch_bounds__(NTHR, 2) fwd(Args a) {
    extern __shared__ __attribute__((aligned(16))) unsigned char lds_raw[];
    LAS unsigned char* lds = (LAS unsigned char*)lds_raw;
    const int tid = threadIdx.x;
    const int G = gridDim.x; const int bx = blockIdx.x; const int vcu = (G % 8 == 0) ? (bx % 8) * (G / 8) + bx / 8 : bx;
    unsigned char* ws = a.ws;
    unsigned* ctl = (unsigned*)(ws + WS_CTL);
    volatile LAS unsigned* MISC = (volatile LAS unsigned*)(lds + 146 * 1024);
    LAS int* pre = (LAS int*)(lds + 147 * 1024);
    if (tid < 64) MISC[tid] = 0u;
    __syncthreads();
    const int lo = a.ph_lo, hi = a.ph_hi;
    XcdBarrier bar; bar.bar = ctl + CW_BAR; bar.x = 0; bar.st = nullptr;
    if (hi - lo > 1) bar = xcd_barrier_post(ctl + CW_BAR, MISC + 8);
#ifndef PHM
#define PHM 0xfffff
#endif
#define IN(k) (((PHM >> (k)) & 1) && lo <= (k) && (k) < hi)
#define SEAM(k) do { if (IN(k) && IN((k) + 1)) xcd_barrier(bar); } while (0)
#define HA ((bf16*)(a.ws + WS_HA))
#define HB ((bf16*)(a.ws + WS_HB))
#define RS ((float*)(a.ws + WS_RSTAT))
#define rinfo ((const int*)(a.ws + WS_RINFO))

    if (IN(0)) { p0_prologue(a, lds, vcu, G); } SEAM(0);
    if (IN(1)) {
        s5_phase(a, lds, vcu, G);
    } SEAM(1);
    if (IN(2)) {
        DenseSched S{(const bf16*)(ws + WS_G0), (const bf16*)(ws + WS_WGLU), 2048, 64, 16, G, bx};
        EpiGLU E{a.in[0], a.in[12], HA};
        GEMM_RUN(2048, S, E);
    } SEAM(2);
    if (IN(3)) { router_phase(a, 0, HA, lds, vcu, G, ctl + CW_RDONE);
        if (vcu < 32) { wait_routers(ctl + CW_RDONE, (unsigned)G); build_lists(ws, ctl + CW_CNT, lds, vcu, G); }
    } SEAM(3);
    if (IN(5)) {
        moe_prefix(ctl + CW_CNT, pre);
        MoeSched S{HA, (const bf16*)(ws + WS_WGU), rinfo, pre, 2048, 4, G, bx, (size_t)1024 * 2048, true};
        EpiGateUp E{(const float*)(ws + WS_RR), (const float*)(ws + WS_RW), (bf16*)(ws + WS_HID), rinfo};
        GEMM_RUN_G(2048, S, E);
        {
            const int tot = pre[32] * 4; const int R = (tot % G == 0) ? 0 : tot % G;
            FillSched SF{(const bf16*)(ws + WS_PBF), (const bf16*)(ws + WS_WPP), 256, 64, 8, G, bx, R};
            EpiStore EF{(bf16*)(ws + WS_PP), D};
            GEMM_RUN_2ND(256, SF, EF); }
    } SEAM(5);
    if (IN(6)) {
        moe_prefix(ctl + CW_CNT, pre);
        MoeSched S{(const bf16*)(ws + WS_HID), (const bf16*)(ws + WS_WDN), rinfo, pre, 512, 8, G, bx, (size_t)2048 * 512, false};
        EpiDown E{(bf16*)(ws + WS_SLOT)};
        GEMM_RUN(512, S, E);
    } SEAM(6);
    if (IN(7)) { combine_phase(HA, (const bf16*)(ws + WS_SLOT), HB, RS, vcu, G); } SEAM(7);
    if (IN(8)) {
        DenseSched S{HB, (const bf16*)(ws + WS_WPG), 2048, 64, 8, G, bx};
        EpiPLE E{HB, (const bf16*)(ws + WS_PP), RS, HA, (float*)(ws + WS_PART)};
        GEMM_RUN(2048, S, E);
    } SEAM(8);
    if (IN(9)) {
        DenseSched S{HA, (const bf16*)(ws + WS_WQKV), 2048, 64, 32, G, bx};
        EpiQKV E{(const float*)(ws + WS_PART), (const float*)(ws + WS_ROPE), (bf16*)(ws + WS_Q), (bf16*)(ws + WS_KB), (bf16*)(ws + WS_VB)};
        GEMM_RUN(2048, S, E);
    } SEAM(9);
    if (IN(10)) { attn_phase(a, lds, vcu, G); } SEAM(10);
    if (IN(11)) { merge_phase(a, vcu, G); } SEAM(11);
    if (IN(12)) {
        DenseSched S{(const bf16*)(ws + WS_O), (const bf16*)(ws + WS_WO), 2048, 64, 8, G, bx};
        EpiResAdd E{HA, HB};
        GEMM_RUN(2048, S, E);
    } SEAM(12);
    if (IN(13)) {
        router_phase(a, 1, HB, lds, vcu, G, ctl + CW_RDONE + 32);
        if (vcu < 32) { wait_routers(ctl + CW_RDONE + 32, (unsigned)G); build_lists(ws, ctl + CW_CNT + 1024, lds, vcu, G); __syncthreads(); }
        const int lane = tid & 63, wave = __builtin_amdgcn_readfirstlane(tid >> 6);
        moe_weights(a, 1, vcu * NWAVES + wave, G * NWAVES, lds + wave * 16384, lane);
    } SEAM(13);
    if (IN(15)) {
        moe_prefix(ctl + CW_CNT + 1024, pre);
        MoeSched S{HB, (const bf16*)(ws + WS_WGU), rinfo, pre, 2048, 4, G, bx, (size_t)1024 * 2048, true};
        EpiGateUp E{(const float*)(ws + WS_RR), (const float*)(ws + WS_RW), (bf16*)(ws + WS_HID), rinfo};
        GEMM_RUN_G(2048, S, E);
        {
            const int tot = pre[32] * 4; const int R = (tot % G == 0) ? 0 : tot % G;
            FillSched SF{(const bf16*)(ws + WS_PBF) + (size_t)T * 256, (const bf16*)(ws + WS_WPP) + (size_t)2048 * 256, 256, 64, 8, G, bx, R};
            EpiStore EF{(bf16*)(ws + WS_PP) + (size_t)T * D, D};
            GEMM_RUN_2ND(256, SF, EF); }
    } SEAM(15);
    if (IN(16)) {
        moe_prefix(ctl + CW_CNT + 1024, pre);
        MoeSched S{(const bf16*)(ws + WS_HID), (const bf16*)(ws + WS_WDN), rinfo, pre, 512, 8, G, bx, (size_t)2048 * 512, false};
        EpiDown E{(bf16*)(ws + WS_SLOT)};
        GEMM_RUN(512, S, E);
    } SEAM(16);
    if (IN(17)) { combine_phase(HB, (const bf16*)(ws + WS_SLOT), HA, RS, vcu, G); } SEAM(17);
    if (IN(18)) {
        DenseSched S{HA, (const bf16*)(ws + WS_WPG) + (size_t)2048 * 2048, 2048, 64, 8, G, bx};
        EpiPLE E{HA, (const bf16*)(ws + WS_PP) + (size_t)T * D, RS, HB, (float*)(ws + WS_PART)};
        GEMM_RUN(2048, S, E);
    } SEAM(18);
    if (IN(19)) { final_phase(HB, a.in[30], a.out, vcu, G); }
#undef IN
#undef SEAM
#undef HA
#undef HB
#undef RS
#undef rinfo
}

extern "C" void kernel_launch(void* const* d_in, const int* in_sizes, int n_in, void* d_out, int out_size, void* d_ws, size_t ws_size, hipStream_t stream) {
    static int grid = 0;
    if (grid == 0) {
        if (n_in != 31 || out_size != T * D || ws_size < WS_END) { fprintf(stderr, "kernel_launch: unexpected shapes (n_in %d, out %d, ws %zu)\n", n_in, out_size, ws_size); grid = -1; return; }
        int dev = 0, cus = 0, per_cu = 0;
        if (hipGetDevice(&dev) != hipSuccess || hipDeviceGetAttribute(&cus, hipDeviceAttributeMultiprocessorCount, dev) != hipSuccess) { grid = -1; return; }
        if (hipFuncSetAttribute((const void*)fwd, hipFuncAttributeMaxDynamicSharedMemorySize, LDS_BYTES) != hipSuccess) { fprintf(stderr, "kernel_launch: hipFuncSetAttribute failed\n"); grid = -1; return; }
        if (hipOccupancyMaxActiveBlocksPerMultiprocessor(&per_cu, (const void*)fwd, NTHR, LDS_BYTES) != hipSuccess || per_cu < 1) fprintf(stderr, "kernel_launch: occupancy query reports %d\n", per_cu);
        (void)hipGetLastError();
        grid = cus;
    }
    if (grid < 0) return;
    if (hipMemsetAsync((char*)d_ws + WS_CTL, 0, CTL_ZERO_BYTES, stream) != hipSuccess) return;
    Args a{};
    for (int i = 0; i < 31; ++i) a.in[i] = (const float*)d_in[i];
    a.out = (float*)d_out; a.ws = (unsigned char*)d_ws;
#if MK_N_LAUNCHES == 1
    a.ph_lo = 0; a.ph_hi = NPH;
    hipLaunchKernelGGL(fwd, dim3(grid), dim3(NTHR), LDS_BYTES, stream, a);
#else
    for (int p = 0; p < NPH; ++p) { a.ph_lo = p; a.ph_hi = p + 1; hipLaunchKernelGGL(fwd, dim3(grid), dim3(NTHR), LDS_BYTES, stream, a); }
#endif
}
```
